# Optimizing an MI355X kernel written in HIP

```python
import math
import jax, jax.numpy as jnp
from jax import lax
import numpy as np

D_MODEL = 1024
BATCH = 4
SEQ = 4096
DEPTH = 4

N_HEADS_A = 4
DIFF_QK_DIM = 64
DIFF_V_DIM = 128
N_HEADS_B = 4
SB_DIM = 64
N_GROUPS_C = 4
SGU_DIM = 64
CHUNK = 128
QBLOCK = 128
WIDTH_A = N_HEADS_A * DIFF_V_DIM
WIDTH_B = N_HEADS_B * SB_DIM
WIDTH_C = N_GROUPS_C * SGU_DIM
D_MIX = WIDTH_A + WIDTH_B + WIDTH_C
IN_WIDTHS = (N_HEADS_A * 2 * DIFF_QK_DIM, N_HEADS_A * 2 * DIFF_QK_DIM, WIDTH_A,
             WIDTH_B, WIDTH_B, WIDTH_B, WIDTH_C, WIDTH_C)
D_IN = 2816
ROPE_THETA = 500000.0
ROPE_DIM = DIFF_QK_DIM // 4
MAX_POS_OFFSET = 1024
MEM_LEN = 256
CROSS_HEADS = 4
CROSS_DIM = 64
CROSS_WIDTH = CROSS_HEADS * CROSS_DIM
N_EXPERT_GROUPS = 4
EXPERTS_PER_GROUP = 4
N_EXPERTS = N_EXPERT_GROUPS * EXPERTS_PER_GROUP
TOP_K_IN_GROUP = 2
D_EXPERT = 512
EPS = 1e-6

kernel_name = "hybrid_diff_stickbreak_sgu_hmoe"


def rmsnorm(x, g):
    xf = x.astype(jnp.float32)
    y = xf * lax.rsqrt(jnp.mean(xf * xf, axis=-1, keepdims=True) + EPS)
    return (y * g.astype(jnp.float32)).astype(x.dtype)


def rotary_tables(positions):
    inv_freq = ROPE_THETA ** (-jnp.arange(0, ROPE_DIM, 2, dtype=jnp.float32) / ROPE_DIM)
    ang = positions.astype(jnp.float32)[..., None] * inv_freq
    return jnp.cos(ang)[:, :, None, None, :], jnp.sin(ang)[:, :, None, None, :]


def partial_rotary(t, cos, sin):
    half = ROPE_DIM // 2
    t1 = t[..., :half].astype(jnp.float32)
    t2 = t[..., half:ROPE_DIM].astype(jnp.float32)
    rot = jnp.concatenate([t1 * cos - t2 * sin, t2 * cos + t1 * sin], axis=-1).astype(t.dtype)
    return jnp.concatenate([rot, t[..., ROPE_DIM:]], axis=-1)


def diff_attention(q, k, v, lam, subln_g, lam_init):
    B, S, H, _, Dm = q.shape
    nb = S // QBLOCK
    qb = q.reshape(B, nb, QBLOCK, H, 2, Dm).transpose(1, 0, 3, 4, 2, 5)
    kt = k.transpose(0, 2, 3, 1, 4)
    vt = v.transpose(0, 2, 1, 3)
    key_pos = jnp.arange(S)
    scale = Dm ** -0.5

    def block(args):
        qi, start = args
        s = jnp.einsum('bhmqd,bhmkd->bhmqk', qi, kt).astype(jnp.float32) * scale
        qpos = start + jnp.arange(QBLOCK)
        causal = key_pos[None, :] <= qpos[:, None]
        p = jax.nn.softmax(jnp.where(causal, s, -jnp.inf), axis=-1)
        a = p[:, :, 0] - lam * p[:, :, 1]
        return jnp.einsum('bhqk,bhkd->bhqd', a.astype(vt.dtype), vt)

    o = lax.map(block, (qb, jnp.arange(nb) * QBLOCK))
    o = o.transpose(1, 0, 3, 2, 4).reshape(B, S, H, v.shape[-1])
    o = rmsnorm(o, subln_g) * (1.0 - lam_init)
    return o.reshape(B, S, H * v.shape[-1])


def stick_breaking(q, k, v):
    B, S, H, D = q.shape
    nb = S // QBLOCK
    qb = q.reshape(B, nb, QBLOCK, H, D).transpose(1, 0, 3, 2, 4)
    kt = k.transpose(0, 2, 1, 3)
    vt = v.transpose(0, 2, 1, 3)
    key_pos = jnp.arange(S)
    scale = D ** -0.5

    def block(args):
        qi, start = args
        z = jnp.einsum('bhqd,bhkd->bhqk', qi, kt).astype(jnp.float32) * scale
        qpos = start + jnp.arange(QBLOCK)
        strict = key_pos[None, :] < qpos[:, None]
        log_keep = jnp.where(strict, jax.nn.log_sigmoid(-z), 0.0)
        after = lax.cumsum(log_keep, axis=3, reverse=True) - log_keep
        w = jnp.where(strict, jnp.exp(jax.nn.log_sigmoid(z) + after), 0.0)
        return jnp.einsum('bhqk,bhkd->bhqd', w.astype(vt.dtype), vt)

    o = lax.map(block, (qb, jnp.arange(nb) * QBLOCK))
    return o.transpose(1, 0, 3, 2, 4).reshape(B, S, H, D)


def chunk_spatial_gating(u, v, sgu_g, w_s, b_s):
    B, S, _ = v.shape
    nc = S // CHUNK
    vn = rmsnorm(v.reshape(B, S, N_GROUPS_C, SGU_DIM), sgu_g.reshape(N_GROUPS_C, SGU_DIM))
    vc = vn.reshape(B, nc, CHUNK, N_GROUPS_C, SGU_DIM)
    causal = jnp.tril(jnp.ones((CHUNK, CHUNK), dtype=bool))
    ws = jnp.where(causal[None], w_s, 0.0)
    s = jnp.einsum('gts,bnsgc->bntgc', ws, vc) + b_s.T[None, None, :, :, None]
    out = u.reshape(B, nc, CHUNK, N_GROUPS_C, SGU_DIM) * s
    return out.reshape(B, S, N_GROUPS_C, SGU_DIM)


def memory_cross_attention(h, m, w_cq, w_ck, w_cv, w_co):
    B, S, _ = h.shape
    M = m.shape[1]
    q = (h @ w_cq).reshape(B, S, CROSS_HEADS, CROSS_DIM)
    k = (m @ w_ck).reshape(B, M, CROSS_HEADS, CROSS_DIM)
    v = (m @ w_cv).reshape(B, M, CROSS_HEADS, CROSS_DIM)
    s = jnp.einsum('bqhd,bkhd->bhqk', q, k).astype(jnp.float32) * (CROSS_DIM ** -0.5)
    p = jax.nn.softmax(s, axis=-1).astype(v.dtype)
    o = jnp.einsum('bhqk,bkhd->bqhd', p, v).reshape(B, S, CROSS_WIDTH)
    return o @ w_co


def hierarchical_moe(h, w_group, b_group, w_router, b_router, w_gate, w_up, w_down):
    B, S, _ = h.shape
    gl = (h @ w_group).astype(jnp.float32) + b_group.astype(jnp.float32)
    gp = jax.nn.softmax(gl, axis=-1)
    _, gidx = lax.top_k(gl, 1)
    p_group = jnp.take_along_axis(gp, gidx, axis=-1)
    el = ((h @ w_router).astype(jnp.float32) + b_router.astype(jnp.float32)).reshape(
        B, S, N_EXPERT_GROUPS, EXPERTS_PER_GROUP)
    sel = jnp.broadcast_to(gidx[..., None], (B, S, 1, EXPERTS_PER_GROUP))
    el_sel = jnp.take_along_axis(el, sel, axis=2)[:, :, 0, :]
    ev, eidx = lax.top_k(el_sel, TOP_K_IN_GROUP)
    w_sel = jax.nn.softmax(ev, axis=-1) * p_group
    expert_ids = gidx * EXPERTS_PER_GROUP + eidx
    gates = jnp.sum(jax.nn.one_hot(expert_ids, N_EXPERTS, dtype=jnp.float32) * w_sel[..., None], axis=2)
    gates = gates.astype(h.dtype)
    y = jnp.zeros_like(h)
    for e in range(N_EXPERTS):
        act = jax.nn.silu(h @ w_gate[e]) * (h @ w_up[e])
        y = y + gates[..., e:e + 1] * (act @ w_down[e])
    return y


def setup_inputs(seed: int = 0) -> dict:
    key = jax.random.key(seed)
    ks = jax.random.split(key, 40)
    cnt = [0]

    def nk():
        cnt[0] += 1
        return ks[cnt[0] - 1]

    def nrm(shape, scale):
        return jax.random.normal(nk(), shape, jnp.float32) * scale

    def gain(shape):
        return 1.0 + 0.02 * jax.random.normal(nk(), shape, jnp.float32)

    L, D = DEPTH, D_MODEL
    x = nrm((BATCH, SEQ, D), 1.0)
    mem = nrm((BATCH, MEM_LEN, D), 1.0)
    positions = (jax.random.randint(nk(), (BATCH, 1), 0, MAX_POS_OFFSET, dtype=jnp.int32)
                 + jnp.arange(SEQ, dtype=jnp.int32)[None, :])
    return {
        "x": x,
        "mem": mem,
        "positions": positions,
        "norm_mix": gain((L, D)),
        "w_in": nrm((L, D, D_IN), D ** -0.5),
        "lam_q1": nrm((L, DIFF_QK_DIM), 0.1),
        "lam_k1": nrm((L, DIFF_QK_DIM), 0.1),
        "lam_q2": nrm((L, DIFF_QK_DIM), 0.1),
        "lam_k2": nrm((L, DIFF_QK_DIM), 0.1),
        "subln_a": gain((L, DIFF_V_DIM)),
        "norm_b_out": gain((L, WIDTH_B)),
        "sgu_norm": gain((L, WIDTH_C)),
        "w_spatial": nrm((L, N_GROUPS_C, CHUNK, CHUNK), CHUNK ** -0.5),
        "b_spatial": gain((L, N_GROUPS_C, CHUNK)),
        "norm_c_out": gain((L, WIDTH_C)),
        "w_out": nrm((L, D_MIX, D), D_MIX ** -0.5),
        "norm_cross": gain((L, D)),
        "norm_mem": gain((L, D)),
        "w_cq": nrm((L, D, CROSS_WIDTH), D ** -0.5),
        "w_ck": nrm((L, D, CROSS_WIDTH), D ** -0.5),
        "w_cv": nrm((L, D, CROSS_WIDTH), D ** -0.5),
        "w_co": nrm((L, CROSS_WIDTH, D), CROSS_WIDTH ** -0.5),
        "norm_ffn": gain((L, D)),
        "w_group": nrm((L, D, N_EXPERT_GROUPS), D ** -0.5),
        "b_group": nrm((L, N_EXPERT_GROUPS), 0.01),
        "w_router": nrm((L, D, N_EXPERTS), D ** -0.5),
        "b_router": nrm((L, N_EXPERTS), 0.01),
        "w_gate": nrm((L, N_EXPERTS, D, D_EXPERT), D ** -0.5),
        "w_up": nrm((L, N_EXPERTS, D, D_EXPERT), D ** -0.5),
        "w_down": nrm((L, N_EXPERTS, D_EXPERT, D), D_EXPERT ** -0.5),
        "norm_final": gain((D,)),
    }


def reference(x, mem, positions, norm_mix, w_in, lam_q1, lam_k1, lam_q2, lam_k2, subln_a,
              norm_b_out, sgu_norm, w_spatial, b_spatial, norm_c_out, w_out, norm_cross, norm_mem,
              w_cq, w_ck, w_cv, w_co, norm_ffn, w_group, b_group, w_router, b_router,
              w_gate, w_up, w_down, norm_final):
    B, S, _ = x.shape
    cos, sin = rotary_tables(positions)
    split_at = np.cumsum(IN_WIDTHS)[:-1].tolist()
    for l in range(DEPTH):
        lam_init = 0.8 - 0.6 * math.exp(-0.3 * l)
        h = rmsnorm(x, norm_mix[l])
        proj = h @ w_in[l]
        aq, ak, av, bq, bk, bv, cu, cv = jnp.split(proj, split_at, axis=-1)
        aq = partial_rotary(aq.reshape(B, S, N_HEADS_A, 2, DIFF_QK_DIM), cos, sin)
        ak = partial_rotary(ak.reshape(B, S, N_HEADS_A, 2, DIFF_QK_DIM), cos, sin)
        av = av.reshape(B, S, N_HEADS_A, DIFF_V_DIM)
        lam = (jnp.exp(jnp.sum(lam_q1[l].astype(jnp.float32) * lam_k1[l].astype(jnp.float32)))
               - jnp.exp(jnp.sum(lam_q2[l].astype(jnp.float32) * lam_k2[l].astype(jnp.float32)))
               + lam_init)
        ya = diff_attention(aq, ak, av, lam, subln_a[l], lam_init)
        yb = stick_breaking(bq.reshape(B, S, N_HEADS_B, SB_DIM), bk.reshape(B, S, N_HEADS_B, SB_DIM),
                            bv.reshape(B, S, N_HEADS_B, SB_DIM))
        yb = rmsnorm(yb, norm_b_out[l].reshape(N_HEADS_B, SB_DIM)).reshape(B, S, WIDTH_B)
        yc = chunk_spatial_gating(jax.nn.gelu(cu), jax.nn.gelu(cv), sgu_norm[l], w_spatial[l], b_spatial[l])
        yc = rmsnorm(yc, norm_c_out[l].reshape(N_GROUPS_C, SGU_DIM)).reshape(B, S, WIDTH_C)
        mix = jnp.concatenate([ya, yb, yc], axis=-1)
        x = x + mix @ w_out[l]
        x = x + memory_cross_attention(rmsnorm(x, norm_cross[l]), rmsnorm(mem, norm_mem[l]),
                                       w_cq[l], w_ck[l], w_cv[l], w_co[l])
        x = x + hierarchical_moe(rmsnorm(x, norm_ffn[l]), w_group[l], b_group[l], w_router[l],
                                 b_router[l], w_gate[l], w_up[l], w_down[l])
    return rmsnorm(x, norm_final)
```

```cpp
#include <hip/hip_runtime.h>
#include <cstdio>
#include <cstdint>

#ifndef MK_MULTI
#define MK_MULTI 1
#endif

#define LAS __attribute__((address_space(3)))
#define GAS __attribute__((address_space(1)))
typedef unsigned short bf16_t;
typedef short bf16x8 __attribute__((ext_vector_type(8)));
typedef short s16x4 __attribute__((ext_vector_type(4)));
typedef float f32x2 __attribute__((ext_vector_type(2)));
typedef float f32x4 __attribute__((ext_vector_type(4)));
typedef float f32x16 __attribute__((ext_vector_type(16)));
typedef unsigned u32x2 __attribute__((ext_vector_type(2)));
typedef unsigned u32x4 __attribute__((ext_vector_type(4)));
typedef __bf16 bf16x2_t __attribute__((ext_vector_type(2)));
typedef GAS unsigned gu32;

constexpr int NB = 4, SEQ = 4096, DM = 1024, MTOK = NB * SEQ, DEPTH = 4, DIN = 2816;
constexpr int MEML = 256, MROWS = NB * MEML;
constexpr int NBUCKET = 24, SLOTCAP = MTOK, MAXCROWS = 22528;
constexpr float EPS = 1e-6f, LOG2E = 1.4426950408889634f;
constexpr int NWAVES = 8, NTHR = 512;

constexpr size_t MiB = 1u << 20;
constexpr size_t WS_CTL = 0, CTL_ZERO_BYTES = 128 * 1024;
constexpr int CW_BAR = 4096;
constexpr int CW_CNT = 16384;
constexpr size_t WS_SS0 = 462 * MiB;
constexpr size_t WS_SS1 = 463 * MiB;
constexpr size_t WS_SSMEM = 2 * MiB;
constexpr size_t WS_LAMV = 2 * MiB + 4096;
constexpr size_t WS_RSTD2 = 2 * MiB + 65536;
constexpr size_t WS_CTOK = 2 * MiB + 131072;
constexpr size_t WS_CRS = 2 * MiB + 262144;
constexpr size_t WS_CWT = 2 * MiB + 393216;
constexpr size_t WS_ROT = 3 * MiB;
constexpr size_t WS_SLOTTOK = 4 * MiB;
constexpr size_t WS_SLOTW = 6 * MiB;
constexpr size_t WS_MEMBF = 10 * MiB;
constexpr size_t WS_KVC = 12 * MiB;
constexpr size_t WS_X = 16 * MiB;
constexpr size_t WS_XB = 80 * MiB;
constexpr size_t WS_PROJ = 112 * MiB;
constexpr size_t WS_HS = 112 * MiB, WS_ACT = 156 * MiB;
constexpr size_t WS_MIX = 200 * MiB;
constexpr size_t WS_QC = 200 * MiB, WS_OC = 208 * MiB;
constexpr size_t WS_WIN = 232 * MiB, WS_WOUT = 254 * MiB, WS_WCKV = 262 * MiB, WS_WCQ = 266 * MiB, WS_WCO = 268 * MiB, WS_WGU = 270 * MiB, WS_WD = 398 * MiB;
constexpr size_t WS_END = 464 * MiB;

constexpr int RING_BYTES = 131072, LDS_BYTES = 147456, MISC_OFF = LDS_BYTES - 1024;

__device__ __forceinline__ unsigned cvtpk(float lo, float hi) { f32x2 v = {lo, hi}; bf16x2_t b = __builtin_convertvector(v, bf16x2_t); return __builtin_bit_cast(unsigned, b); }
__device__ __forceinline__ float bf2f(unsigned short u) { return __builtin_bit_cast(float, (unsigned)u << 16); }
__device__ __forceinline__ float bflo(unsigned u) { return __builtin_bit_cast(float, u << 16); }
__device__ __forceinline__ float bfhi(unsigned u) { return __builtin_bit_cast(float, u & 0xffff0000u); }
__device__ __forceinline__ float ex2(float x) { return __builtin_amdgcn_exp2f(x); }
__device__ __forceinline__ float lg2(float x) { return __builtin_amdgcn_logf(x); }
__device__ __forceinline__ float wave_sum(float v) {
#pragma unroll
    for (int o = 1; o < 64; o <<= 1) v += __shfl_xor(v, o);
    return v;
}
__device__ __forceinline__ float swap32(float v) {
    auto rr = __builtin_amdgcn_permlane32_swap(__float_as_uint(v), __float_as_uint(v), false, false);
    return (threadIdx.x & 32) ? __uint_as_float(rr[0]) : __uint_as_float(rr[1]);
}
__device__ __forceinline__ int crow(int r, int hi) { return (r & 3) + 8 * (r >> 2) + 4 * hi; }
__device__ __forceinline__ float gelu_tanh(float x) {
    const float u = x * (0.7978845608028654f + 0.035677408136300125f * x * x);
    return x * __builtin_amdgcn_rcpf(1.f + ex2(-2.f * LOG2E * u));
}
__device__ __forceinline__ float sum16(const float* p) {
    const f32x4 a = *(const f32x4*)p, b = *(const f32x4*)(p + 4), c = *(const f32x4*)(p + 8), d = *(const f32x4*)(p + 12);
    return (((a[0] + a[1]) + (a[2] + a[3])) + ((b[0] + b[1]) + (b[2] + b[3]))) + (((c[0] + c[1]) + (c[2] + c[3])) + ((d[0] + d[1]) + (d[2] + d[3])));
}
#define VM_WAIT() asm volatile("s_waitcnt vmcnt(0)" ::: "memory")
#define LDS_WAIT() asm volatile("s_waitcnt lgkmcnt(0)" ::: "memory")

#define XB_TMO      128
#define XB_XCNT(j)  (256  + 64 * (j))
#define XB_XSUB(j)  (1280 + 64 * (j))
#define XB_XGEN(j)  (2304 + 64 * (j))
#define XB_TOP      3328
#define XB_TOPGEN   3392
#define XCD_BAR_WORDS 3456
#define XB_SPIN_CAP (1u << 18)
__device__ __forceinline__ unsigned xb_ld(unsigned* p)              { return __hip_atomic_load(p, __ATOMIC_RELAXED, __HIP_MEMORY_SCOPE_AGENT); }
__device__ __forceinline__ unsigned xb_add(unsigned* p, unsigned v) { return __hip_atomic_fetch_add(p, v, __ATOMIC_RELAXED, __HIP_MEMORY_SCOPE_AGENT); }
__device__ __forceinline__ unsigned xb_xcc_id() { return (unsigned)__builtin_amdgcn_s_getreg((3 << 11) | 20) & 0xFu; }
#define XB_SPIN(cond, bar) do { unsigned _sp = 0; while (cond) { __builtin_amdgcn_s_sleep(1); \
    if ((++_sp & 255u) == 0u) { if (xb_ld(&(bar)[XB_TMO])) break; if (_sp > XB_SPIN_CAP) { atomicAdd(&(bar)[XB_TMO], 1u); break; } } } } while (0)
struct XcdBarrier { unsigned* bar; unsigned x; volatile LAS unsigned* st; };
__device__ __forceinline__ XcdBarrier xcd_barrier_post(unsigned* bar, volatile LAS unsigned* st) {
    XcdBarrier b; b.bar = bar; b.x = xb_xcc_id(); b.st = st;
    if (threadIdx.x == 0) (void)xb_add(&bar[XB_XCNT(b.x)], 1u);
    return b;
}
__device__ __forceinline__ void xcd_barrier_complete(unsigned* bar, unsigned x, unsigned& nloc, unsigned& nx) {
    const unsigned G = gridDim.x * gridDim.y * gridDim.z;
    unsigned sum, cnt, mine, sp = 0u;
    for (;;) {
        sum = 0u; cnt = 0u; mine = 0u;
#pragma unroll
        for (unsigned j = 0; j < 16; ++j) { const unsigned c = xb_ld(&bar[XB_XCNT(j)]); sum += c; cnt += (c > 0u) ? 1u : 0u; mine = (j == x) ? c : mine; }
        if (sum == G) break;
        __builtin_amdgcn_s_sleep(1);
        if ((++sp & 255u) == 0u) { if (xb_ld(&bar[XB_TMO])) break; if (sp > XB_SPIN_CAP) { atomicAdd(&bar[XB_TMO], 1u); break; } }
    }
    nloc = mine > 0u ? mine : 1u; nx = cnt > 0u ? cnt : 1u;
}
__device__ __forceinline__ void xcd_barrier(const XcdBarrier& b) {
    asm volatile("s_waitcnt vmcnt(0)" ::: "memory");
    __syncthreads();
    if (threadIdx.x == 0) {
        unsigned* bar = b.bar;
        __builtin_amdgcn_s_waitcnt(0);
        unsigned nloc = b.st[0], nx = b.st[1];
        if (nloc == 0u) { xcd_barrier_complete(bar, b.x, nloc, nx); b.st[0] = nloc; b.st[1] = nx; }
        const unsigned old = xb_add(&bar[XB_XSUB(b.x)], 1u);
        const unsigned gen = old / nloc;
        if (old + 1u == (gen + 1u) * nloc) {
            __builtin_amdgcn_fence(__ATOMIC_RELEASE, "agent");
            asm volatile("s_waitcnt vmcnt(0)" ::: "memory");
            const unsigned og = xb_add(&bar[XB_TOP], 1u);
            const unsigned tg = og / nx;
            if (og + 1u == (tg + 1u) * nx) xb_add(&bar[XB_TOPGEN], 1u);
            else XB_SPIN(xb_ld(&bar[XB_TOPGEN]) == tg, bar);
            __builtin_amdgcn_fence(__ATOMIC_ACQUIRE, "agent");
            xb_add(&bar[XB_XGEN(b.x)], 1u);
            asm volatile("s_waitcnt vmcnt(0)" ::: "memory");
        } else {
            XB_SPIN(xb_ld(&bar[XB_XGEN(b.x)]) == gen, bar);
            __builtin_amdgcn_fence(__ATOMIC_ACQUIRE, "agent");
            asm volatile("s_waitcnt vmcnt(0)" ::: "memory");
        }
    }
    __syncthreads();
}

namespace pg8 {
constexpr int BM = 256, BK = 64, HALF = 128, HTB = HALF * BK * 2, NXCD = 8, WGM = 8;
__host__ __device__ __forceinline__ int lds_byte(int r, int c) { const int st = (r >> 4) * 2 + (c >> 5), rr = r & 15, cc = c & 31, ob = rr * 64 + cc * 2; return st * 1024 + (ob ^ (((ob >> 9) & 1) << 5)); }
__host__ __device__ __forceinline__ void stage_rc(int b, int& R, int& C) { const int st = b / 1024, sb = b % 1024, swz = sb ^ (((sb >> 9) & 1) << 5); R = (st >> 1) * 16 + swz / 64; C = (st & 1) * 32 + (swz % 64) / 2; }
__host__ __device__ __forceinline__ int perm32(int rho) { const int n = rho >> 4, i = rho & 15; return 8 * (i >> 2) + 4 * n + (i & 3); }

struct Unit { const char* A; const char* B; const char* B2; int pm, pn, aux; };
struct GemmP { int lda, ldb, K; size_t hstepB; int ksw; };

struct DenseOrder {
    const char* A; const char* Bt; int lda, ldb, nM, nN, nwg, G, c;
    __device__ void init(const void* A_, const void* Bt_, int lda_, int ldb_, int M, int N, int G_, int c_) { A = (const char*)A_; Bt = (const char*)Bt_; lda = lda_; ldb = ldb_; nM = M / BM; nN = N / BM; nwg = nM * nN; G = G_; c = c_; }
    __device__ bool next(int i, Unit& u) const {
        const long L = (long)i * G + c; if (L >= nwg) return false;
        int wgid = (int)L; { const int q = nwg / NXCD, r = nwg % NXCD, xcd = wgid % NXCD, off = wgid / NXCD; wgid = (xcd < r ? xcd * (q + 1) : r * (q + 1) + (xcd - r) * q) + off; }
        const int nig = WGM * nN, gid = wgid / nig, fm = gid * WGM, gsz = (nM - fm) < WGM ? (nM - fm) : WGM;
        u.pm = fm + ((wgid % nig) % gsz); u.pn = (wgid % nig) / gsz; u.aux = 0;
        u.A = A + (size_t)u.pm * BM * lda * 2; u.B = Bt + (size_t)u.pn * BM * ldb * 2; u.B2 = u.B; return true;
    }
};

template <class Epi, class Sched>
__device__ __forceinline__ void gemm_phase(LAS unsigned char* lds, const GemmP g, const Sched& S, const Epi& E) {
    int tid = threadIdx.x; asm volatile("" : "+v"(tid));
    const int wid = __builtin_amdgcn_readfirstlane(tid >> 6), lane = tid & 63, wr = wid >> 2, wc = wid & 3, fr = lane & 15, fq = lane >> 4;
    const int K = g.K, nt = K / BK, ksw = g.ksw;
    unsigned voffA[2], voffB[2];
#pragma unroll
    for (int i = 0; i < 2; ++i) { int R, C; stage_rc(tid * 16 + i * 8192, R, C); const int Rb = (R & ~31) + perm32(R & 31);
        voffA[i] = (unsigned)(R * g.lda + C) * 2u; voffB[i] = (unsigned)(Rb * g.ldb + C) * 2u; }
    const size_t kstep = (size_t)(BK * 2);
    const size_t hstepA = (size_t)HALF * g.lda * 2, hstepB = g.hstepB;
    const unsigned ldsw = (unsigned)wid * 1024u;
    const int aoff = lds_byte(wr * 64 + fr, fq * 8), boff = lds_byte(wc * 32 + fr, fq * 8);
#define PG8_SA(b, h) (((b) * 2 + (h)) * HTB)
#define PG8_SB(b, h) ((4 + (b) * 2 + (h)) * HTB)
#define PG8_STAGE(bufoff, gbase, voff) do { _Pragma("unroll") for (int _i = 0; _i < 2; ++_i) \
        __builtin_amdgcn_global_load_lds((const unsigned*)((const char*)(gbase) + (voff)[_i]), (LAS unsigned*)(lds + (bufoff) + ldsw + _i * 8192), 16, 0, 0); } while (0)
#define PG8_LDA(dst, b, h) do { _Pragma("unroll") for (int m = 0; m < 4; ++m) _Pragma("unroll") for (int k = 0; k < 2; ++k) dst[m][k] = *(const LAS bf16x8*)(lds + PG8_SA(b, h) + aoff + m * 2048 + k * 1024); } while (0)
#define PG8_LDB(dst, b, h) do { _Pragma("unroll") for (int n = 0; n < 2; ++n) _Pragma("unroll") for (int k = 0; k < 2; ++k) dst[n][k] = *(const LAS bf16x8*)(lds + PG8_SB(b, h) + boff + n * 2048 + k * 1024); } while (0)
#define PG8_MMA(ai, bj, At, Bt) do { __builtin_amdgcn_s_setprio(1); _Pragma("unroll") for (int m = 0; m < 4; ++m) _Pragma("unroll") for (int n = 0; n < 2; ++n) _Pragma("unroll") for (int k = 0; k < 2; ++k) \
        acc[ai][bj][m][n] = __builtin_amdgcn_mfma_f32_16x16x32_bf16(Bt[n][k], At[m][k], acc[ai][bj][m][n], 0, 0, 0); __builtin_amdgcn_s_setprio(0); } while (0)
#define PG8_WAIT_V(n) asm volatile("s_waitcnt vmcnt(" #n ")" ::: "memory")
#define PG8_WAIT_L(n) asm volatile("s_waitcnt lgkmcnt(" #n ")" ::: "memory")
#define PG8_BAR __builtin_amdgcn_s_barrier()
#define PG8_SCHED __builtin_amdgcn_sched_barrier(0)
    Unit cur, nxt; int ui = 0;
    if (!S.next(0, cur)) return;
    f32x4 acc[2][2][4][2];
#pragma unroll
    for (int a = 0; a < 2; ++a)
#pragma unroll
        for (int b = 0; b < 2; ++b)
#pragma unroll
            for (int m = 0; m < 4; ++m)
#pragma unroll
                for (int n = 0; n < 2; ++n) acc[a][b][m][n] = (f32x4){0.f, 0.f, 0.f, 0.f};
    bf16x8 At[4][2], B0[2][2], B1[2][2];
    const char* cA = cur.A; const char* cB = cur.B; const char* cB2 = cur.B2;
    PG8_STAGE(PG8_SB(0, 0), cB, voffB); PG8_STAGE(PG8_SB(0, 1), cB + hstepB, voffB); PG8_STAGE(PG8_SA(0, 0), cA, voffA); PG8_STAGE(PG8_SA(0, 1), cA + hstepA, voffA);
    if (wr == 1) PG8_BAR;
    PG8_WAIT_V(2); PG8_BAR;
    PG8_STAGE(PG8_SB(1, 0), cB + kstep, voffB); PG8_STAGE(PG8_SA(1, 0), cA + kstep, voffA); PG8_STAGE(PG8_SB(1, 1), cB + hstepB + kstep, voffB);
    PG8_WAIT_V(6); PG8_BAR;
    for (;;) {
        const bool has_next = S.next(ui + 1, nxt);
        const char* nA = has_next ? nxt.A : cA; const char* nB = has_next ? nxt.B : cB;
#pragma unroll 1
        for (int t = 0; t < nt; t += 2) {
            const bool last = (t == nt - 2);
            const char* a1 = cA + (size_t)(t + 1) * kstep;
            const char* a2 = last ? nA : cA + (size_t)(t + 2) * kstep;
            const char* b2 = last ? nB : ((t + 2 < ksw) ? cB : cB2) + (size_t)(t + 2) * kstep;
            const char* a3 = a2 + kstep; const char* b3 = b2 + kstep;
            PG8_LDB(B0, 0, 0); PG8_LDB(B1, 0, 1); PG8_SCHED; PG8_LDA(At, 0, 0); PG8_STAGE(PG8_SA(1, 1), a1 + hstepA, voffA);
            PG8_WAIT_V(8); PG8_WAIT_L(0); PG8_BAR; PG8_MMA(0, 0, At, B0); PG8_MMA(0, 1, At, B1); PG8_BAR; PG8_SCHED;
            PG8_LDA(At, 0, 1); PG8_STAGE(PG8_SB(0, 0), b2, voffB); PG8_STAGE(PG8_SB(0, 1), b2 + hstepB, voffB); PG8_STAGE(PG8_SA(0, 0), a2, voffA);
            PG8_WAIT_V(8); PG8_WAIT_L(0); PG8_BAR; PG8_MMA(1, 0, At, B0); PG8_MMA(1, 1, At, B1); PG8_BAR; PG8_SCHED;
            PG8_LDB(B0, 1, 0); PG8_LDB(B1, 1, 1); PG8_SCHED; PG8_LDA(At, 1, 0); PG8_STAGE(PG8_SA(0, 1), a2 + hstepA, voffA);
            PG8_WAIT_V(8); PG8_WAIT_L(0); PG8_BAR; PG8_MMA(0, 0, At, B0); PG8_MMA(0, 1, At, B1); PG8_BAR; PG8_SCHED;
            PG8_LDA(At, 1, 1); PG8_STAGE(PG8_SB(1, 0), b3, voffB); PG8_STAGE(PG8_SB(1, 1), b3 + hstepB, voffB); PG8_STAGE(PG8_SA(1, 0), a3, voffA);
            PG8_WAIT_V(8); PG8_WAIT_L(0); PG8_BAR; PG8_MMA(1, 0, At, B0); PG8_MMA(1, 1, At, B1); PG8_BAR; PG8_SCHED;
        }
        if (wr == 0) PG8_BAR;
        E(acc, cur, wr, wc, fr, fq);
        if (!has_next) break;
#pragma unroll
        for (int a = 0; a < 2; ++a)
#pragma unroll
            for (int b = 0; b < 2; ++b)
#pragma unroll
                for (int m = 0; m < 4; ++m)
#pragma unroll
                    for (int n = 0; n < 2; ++n) acc[a][b][m][n] = (f32x4){0.f, 0.f, 0.f, 0.f};
        cur = nxt; cA = nA; cB = nB; cB2 = nxt.B2; ++ui;
        if (wr == 1) PG8_BAR;
    }
    PG8_WAIT_V(0);
    PG8_BAR;
#undef PG8_SA
#undef PG8_SB
#undef PG8_STAGE
#undef PG8_LDA
#undef PG8_LDB
#undef PG8_MMA
#undef PG8_WAIT_V
#undef PG8_WAIT_L
#undef PG8_BAR
#undef PG8_SCHED
}
}
typedef f32x4 Acc[2][2][4][2];

struct EpiInProj {
    bf16_t* P; const float* ss; const float* rot;
    __device__ __forceinline__ void operator()(const Acc& acc, const pg8::Unit& u, int wr, int wc, int fr, int fq) const {
        const int pn = u.pn;
        const float qs = (pn < 2 || pn == 6) ? 0.125f : 1.f;
        const bool rotary = (pn < 4) && ((wc & 1) == 0);
        const bool gelu = (pn >= 9);
#pragma unroll
        for (int ai = 0; ai < 2; ++ai)
#pragma unroll
            for (int m = 0; m < 4; ++m) {
                const int row = u.pm * 256 + ai * 128 + wr * 64 + m * 16 + fr;
                const float rs = __builtin_amdgcn_rsqf(sum16(ss + (size_t)row * 16) * (1.f / DM) + EPS) * qs;
                f32x4 cs[4];
                if (rotary) {
#pragma unroll
                    for (int j = 0; j < 4; ++j) cs[j] = *(const f32x4*)(rot + (size_t)row * 16 + 4 * j);
                }
#pragma unroll
                for (int bj = 0; bj < 2; ++bj) {
                    float v[8];
#pragma unroll
                    for (int e = 0; e < 4; ++e) { v[e] = acc[ai][bj][m][0][e] * rs; v[4 + e] = acc[ai][bj][m][1][e] * rs; }
                    if (rotary) {
#pragma unroll
                        for (int e = 0; e < 8; ++e) {
                            const float p = __shfl_xor(v[e], 16);
                            const float c = cs[e >> 2][e & 3], s = cs[2 + (e >> 2)][e & 3];
                            const float r0 = v[e] * c - p * s, r1 = v[e] * c + p * s;
                            v[e] = (fq == 0) ? r0 : ((fq == 1) ? r1 : v[e]);
                        }
                    }
                    if (gelu) {
#pragma unroll
                        for (int e = 0; e < 8; ++e) v[e] = gelu_tanh(v[e]);
                    }
                    u32x4 w; w.x = cvtpk(v[0], v[1]); w.y = cvtpk(v[2], v[3]); w.z = cvtpk(v[4], v[5]); w.w = cvtpk(v[6], v[7]);
                    *(u32x4*)(P + (size_t)row * DIN + pn * 256 + bj * 128 + wc * 32 + fq * 8) = w;
                }
            }
    }
};
struct EpiScale {
    bf16_t* O; int ldc; const float* ss; int nss; float scale;
    __device__ __forceinline__ void operator()(const Acc& acc, const pg8::Unit& u, int wr, int wc, int fr, int fq) const {
#pragma unroll
        for (int ai = 0; ai < 2; ++ai)
#pragma unroll
            for (int m = 0; m < 4; ++m) {
                const int row = u.pm * 256 + ai * 128 + wr * 64 + m * 16 + fr;
                const float rs = __builtin_amdgcn_rsqf((nss == 16 ? sum16(ss + (size_t)row * 16) : ss[row]) * (1.f / DM) + EPS) * scale;
#pragma unroll
                for (int bj = 0; bj < 2; ++bj) {
                    const f32x4 a = acc[ai][bj][m][0] * rs, b = acc[ai][bj][m][1] * rs;
                    u32x4 w; w.x = cvtpk(a[0], a[1]); w.y = cvtpk(a[2], a[3]); w.z = cvtpk(b[0], b[1]); w.w = cvtpk(b[2], b[3]);
                    *(u32x4*)(O + (size_t)row * ldc + u.pn * 256 + bj * 128 + wc * 32 + fq * 8) = w;
                }
            }
    }
};
struct EpiResid {
    const float* Xi; float* Xo; bf16_t* XB; float* ssout; const int* rowmap;
    __device__ __forceinline__ void operator()(const Acc& acc, const pg8::Unit& u, int wr, int wc, int fr, int fq) const {
#pragma unroll
        for (int ai = 0; ai < 2; ++ai)
#pragma unroll
            for (int m = 0; m < 4; ++m) {
                const int r = ai * 128 + wr * 64 + m * 16 + fr;
                int row = u.pm * 256 + r;
                if (rowmap) row = rowmap[u.aux + r];
                float sq = 0.f;
                if (row >= 0) {
#pragma unroll
                    for (int bj = 0; bj < 2; ++bj) {
                        const size_t o = (size_t)row * DM + u.pn * 256 + bj * 128 + wc * 32 + fq * 8;
                        f32x4 a = *(const f32x4*)(Xi + o), b = *(const f32x4*)(Xi + o + 4);
                        a += acc[ai][bj][m][0]; b += acc[ai][bj][m][1];
                        *(f32x4*)(Xo + o) = a; *(f32x4*)(Xo + o + 4) = b;
                        sq += a[0] * a[0] + a[1] * a[1] + a[2] * a[2] + a[3] * a[3] + b[0] * b[0] + b[1] * b[1] + b[2] * b[2] + b[3] * b[3];
                        u32x4 w; w.x = cvtpk(a[0], a[1]); w.y = cvtpk(a[2], a[3]); w.z = cvtpk(b[0], b[1]); w.w = cvtpk(b[2], b[3]);
                        *(u32x4*)(XB + o) = w;
                    }
                }
                sq += __shfl_xor(sq, 16); sq += __shfl_xor(sq, 32);
                if (fq == 0 && row >= 0 && ssout) ssout[(size_t)row * 16 + u.pn * 4 + wc] = sq;
            }
    }
};
struct EpiG1 {
    bf16_t* ACT; const float* crs; const float* cwt;
    __device__ __forceinline__ void operator()(const Acc& acc, const pg8::Unit& u, int wr, int wc, int fr, int fq) const {
        const int sel = u.pn >> 2, ch = u.pn & 3;
#pragma unroll
        for (int ai = 0; ai < 2; ++ai)
#pragma unroll
            for (int m = 0; m < 4; ++m) {
                const int cr = u.aux + ai * 128 + wr * 64 + m * 16 + fr;
                const float rs = crs[cr], wt = cwt[2 * cr + sel];
                float v[8];
#pragma unroll
                for (int n = 0; n < 2; ++n)
#pragma unroll
                    for (int e = 0; e < 4; ++e) {
                        const float gg = acc[ai][0][m][n][e] * rs, uu = acc[ai][1][m][n][e] * rs;
                        v[4 * n + e] = gg * __builtin_amdgcn_rcpf(1.f + ex2(-LOG2E * gg)) * uu * wt;
                    }
                u32x4 w; w.x = cvtpk(v[0], v[1]); w.y = cvtpk(v[2], v[3]); w.z = cvtpk(v[4], v[5]); w.w = cvtpk(v[6], v[7]);
                *(u32x4*)(ACT + (size_t)cr * DM + sel * 512 + ch * 128 + wc * 32 + fq * 8) = w;
            }
    }
};

__device__ __forceinline__ void bucket_experts(int b, int& elo, int& ehi) {
    const int grp = b / 6, p = b % 6;
    const int lo = p < 3 ? 0 : (p < 5 ? 1 : 2), hi = p < 3 ? p + 1 : (p < 5 ? p - 1 : 3);
    elo = grp * 4 + lo; ehi = grp * 4 + hi;
}
struct MoeOrder {
    const volatile LAS int* pre; const char* A; const char* W; int layer, G, vcu; bool g2;
    __device__ bool next(int i, pg8::Unit& u) const {
        const int ncol = g2 ? 4 : 8;
        const long L = (long)i * G + vcu; if (L >= (long)pre[NBUCKET] * ncol) return false;
        const int rt = (int)(L / ncol), pn = (int)(L % ncol);
        const int b = pre[32 + rt];
        int elo, ehi; bucket_experts(b, elo, ehi);
        u.pm = rt; u.pn = pn; u.aux = rt * 256;
        u.A = A + (size_t)rt * 256 * DM * 2;
        if (!g2) { const int e = (pn < 4) ? elo : ehi; u.B = W + ((size_t)(layer * 16 + e) * 1024 + (pn & 3) * 128) * DM * 2; u.B2 = u.B; }
        else { u.B = W + ((size_t)(layer * 16 + elo) * 1024 + pn * 256) * 512 * 2; u.B2 = W + ((size_t)(layer * 16 + ehi) * 1024 + pn * 256) * 512 * 2 - 8 * 128; }
        return true;
    }
};

__device__ __forceinline__ f32x16 mfma32(bf16x8 a, bf16x8 b, f32x16 c) { return __builtin_amdgcn_mfma_f32_32x32x16_bf16(a, b, c, 0, 0, 0); }
typedef short v4i16_t __attribute__((ext_vector_type(4)));
__device__ __forceinline__ s16x4 vtr(const LAS unsigned char* p) { return __builtin_bit_cast(s16x4, __builtin_amdgcn_ds_read_tr16_b64_v4i16((LAS v4i16_t*)p)); }
__device__ __forceinline__ bf16x8 vfrag(const LAS unsigned char* p) { const s16x4 lo = vtr(p), hi = vtr(p + 512); return (bf16x8){lo[0], lo[1], lo[2], lo[3], hi[0], hi[1], hi[2], hi[3]}; }

template <int NMAP, int VD, bool CAUSAL>
__device__ __forceinline__ void flash_sweep(LAS unsigned char* lds, const bf16_t* Qrow, const bf16_t* Kbase, int kpitch, const bf16_t* Vbase, int vpitch, int NT, int q0w,
                                            f32x16 (&o)[VD / 32], float& lsum) {
    constexpr int NDB = VD / 32, KB = NMAP * 8192, BUF = KB + NDB * 4096, PPW = (NMAP * 8 + NDB * 4) / 8;
    int tid = threadIdx.x; asm volatile("" : "+v"(tid));
    const int lane = tid & 63, r32 = lane & 31, hi = lane >> 5, wid = __builtin_amdgcn_readfirstlane(tid >> 6);
    const int map = (NMAP == 2) ? (wid >> 2) : 0;
    bf16x8 qf[4];
#pragma unroll
    for (int ks = 0; ks < 4; ++ks) qf[ks] = *(const bf16x8*)(Qrow + ks * 16 + hi * 8);
#pragma unroll
    for (int d = 0; d < NDB; ++d) o[d] = (f32x16){0.f, 0.f, 0.f, 0.f, 0.f, 0.f, 0.f, 0.f, 0.f, 0.f, 0.f, 0.f, 0.f, 0.f, 0.f, 0.f};
    float mrow = -INFINITY; lsum = 0.f;
    auto issue = [&](int t, int buf) {
#pragma unroll
        for (int i = 0; i < PPW; ++i) {
            const int p = wid * PPW + i;
            const bf16_t* src;
            if (p < NMAP * 8) src = Kbase + (size_t)(64 * t + lane) * kpitch + (p >> 3) * 64 + (p & 7) * 8;
            else { const int pv = p - NMAP * 8; src = Vbase + (size_t)(64 * t + 16 * (pv & 3) + (lane >> 2)) * vpitch + (pv >> 2) * 32 + (lane & 3) * 8; }
            __builtin_amdgcn_global_load_lds((const unsigned*)src, (LAS unsigned*)(lds + buf * BUF + p * 1024), 16, 0, 0);
        }
    };
    const int vlane = ((lane >> 4) & 1) * 32 + (lane & 3) * 8 + (4 * hi + ((lane & 15) >> 2)) * 64;
    issue(0, 0);
    for (int t = 0; t < NT; ++t) {
        VM_WAIT(); __syncthreads();
        if (t + 1 < NT) issue(t + 1, (t + 1) & 1);
        if (CAUSAL && 64 * t > q0w + 31) continue;
        const LAS unsigned char* kb = lds + (t & 1) * BUF + map * 8192 + hi * 1024 + r32 * 16;
        const LAS unsigned char* vb = lds + (t & 1) * BUF + KB + vlane;
        f32x16 p0 = (f32x16){0.f, 0.f, 0.f, 0.f, 0.f, 0.f, 0.f, 0.f, 0.f, 0.f, 0.f, 0.f, 0.f, 0.f, 0.f, 0.f}, p1 = p0;
#pragma unroll
        for (int ks = 0; ks < 4; ++ks) {
            const bf16x8 k0 = *(const LAS bf16x8*)(kb + ks * 2048), k1 = *(const LAS bf16x8*)(kb + ks * 2048 + 512);
            p0 = mfma32(k0, qf[ks], p0); p1 = mfma32(k1, qf[ks], p1);
        }
        if (CAUSAL && 64 * t + 63 > q0w) {
            const int qq = q0w + r32 - 64 * t;
#pragma unroll
            for (int r = 0; r < 16; ++r) { const int kv = crow(r, hi); if (kv > qq) p0[r] = -INFINITY; if (kv + 32 > qq) p1[r] = -INFINITY; }
        }
        float rm = fmaxf(p0[0], p1[0]);
#pragma unroll
        for (int r = 1; r < 16; ++r) rm = fmaxf(rm, fmaxf(p0[r], p1[r]));
        rm = fmaxf(rm, swap32(rm));
        const float mnew = fmaxf(mrow, rm);
        if (__any(mnew > mrow)) {
            const float alpha = ex2((mrow - mnew) * LOG2E);
            lsum *= alpha;
#pragma unroll
            for (int d = 0; d < NDB; ++d)
#pragma unroll
                for (int r = 0; r < 16; ++r) o[d][r] *= alpha;
            mrow = mnew;
        }
        const float mc = mrow * LOG2E;
        float ls = 0.f;
#pragma unroll
        for (int r = 0; r < 16; ++r) { p0[r] = ex2(p0[r] * LOG2E - mc); p1[r] = ex2(p1[r] * LOG2E - mc); ls += p0[r] + p1[r]; }
        lsum += ls;
        bf16x8 pw[4];
        { u32x4 w;
          w.x = cvtpk(p0[0], p0[1]); w.y = cvtpk(p0[2], p0[3]); w.z = cvtpk(p0[4], p0[5]); w.w = cvtpk(p0[6], p0[7]); pw[0] = __builtin_bit_cast(bf16x8, w);
          w.x = cvtpk(p0[8], p0[9]); w.y = cvtpk(p0[10], p0[11]); w.z = cvtpk(p0[12], p0[13]); w.w = cvtpk(p0[14], p0[15]); pw[1] = __builtin_bit_cast(bf16x8, w);
          w.x = cvtpk(p1[0], p1[1]); w.y = cvtpk(p1[2], p1[3]); w.z = cvtpk(p1[4], p1[5]); w.w = cvtpk(p1[6], p1[7]); pw[2] = __builtin_bit_cast(bf16x8, w);
          w.x = cvtpk(p1[8], p1[9]); w.y = cvtpk(p1[10], p1[11]); w.z = cvtpk(p1[12], p1[13]); w.w = cvtpk(p1[14], p1[15]); pw[3] = __builtin_bit_cast(bf16x8, w); }
#pragma unroll
        for (int d = 0; d < NDB; ++d)
#pragma unroll
            for (int ks = 0; ks < 4; ++ks) o[d] = mfma32(vfrag(vb + d * 4096 + ks * 1024), pw[ks], o[d]);
    }
    lsum += swap32(lsum);
    __syncthreads();
}

__device__ __forceinline__ void diff_unit(LAS unsigned char* lds, const bf16_t* P, bf16_t* MIX, int b, int h, int qb, float lam, float oscale, const float* subln) {
    int tid = threadIdx.x; asm volatile("" : "+v"(tid));
    const int lane = tid & 63, r32 = lane & 31, hi = lane >> 5, wid = __builtin_amdgcn_readfirstlane(tid >> 6);
    const int map = wid >> 2, qs = wid & 3, q0w = qb * 128 + qs * 32;
    const size_t rowb = (size_t)b * SEQ;
    f32x16 o[4]; float lsum;
    flash_sweep<2, 128, true>(lds, P + (rowb + q0w + r32) * DIN + h * 128 + map * 64, P + rowb * DIN + 512 + h * 128, DIN, P + rowb * DIN + 1024 + h * 128, DIN,
                              2 * (qb + 1), q0w, o, lsum);
    const float inv = 1.f / lsum;
    LAS float* xch = (LAS float*)(lds + 65536) + qs * 4096;
    if (map == 1) {
#pragma unroll
        for (int d = 0; d < 4; ++d)
#pragma unroll
            for (int r = 0; r < 16; ++r) xch[(d * 16 + r) * 64 + lane] = o[d][r] * inv;
    }
    __syncthreads();
    if (map == 0) {
        float sq = 0.f;
#pragma unroll
        for (int d = 0; d < 4; ++d)
#pragma unroll
            for (int r = 0; r < 16; ++r) { const float v = o[d][r] * inv - lam * xch[(d * 16 + r) * 64 + lane]; o[d][r] = v; sq += v * v; }
        sq += swap32(sq);
        const float rs = __builtin_amdgcn_rsqf(sq * (1.f / 128.f) + EPS) * oscale;
        bf16_t* orow = MIX + (rowb + q0w + r32) * DM + h * 128;
#pragma unroll
        for (int d = 0; d < 4; ++d)
#pragma unroll
            for (int g4 = 0; g4 < 4; ++g4) {
                const int dd = 32 * d + 8 * g4 + 4 * hi;
                const f32x4 gn = *(const f32x4*)(subln + dd);
                u32x2 w; w.x = cvtpk(o[d][4 * g4] * rs * gn[0], o[d][4 * g4 + 1] * rs * gn[1]); w.y = cvtpk(o[d][4 * g4 + 2] * rs * gn[2], o[d][4 * g4 + 3] * rs * gn[3]);
                *(u32x2*)(orow + dd) = w;
            }
    }
    __syncthreads();
}

__device__ __forceinline__ void cross_unit(LAS unsigned char* lds, const bf16_t* QC, const bf16_t* KVC, bf16_t* OC, int b, int h, int qb, int layer) {
    int tid = threadIdx.x; asm volatile("" : "+v"(tid));
    const int lane = tid & 63, r32 = lane & 31, hi = lane >> 5, wid = __builtin_amdgcn_readfirstlane(tid >> 6);
    const size_t row = (size_t)b * SEQ + qb * 256 + wid * 32 + r32;
    const bf16_t* kbase = KVC + (size_t)b * MEML * 2048 + layer * 512 + h * 64;
    f32x16 o[2]; float lsum;
    flash_sweep<1, 64, false>(lds, QC + row * 256 + h * 64, kbase, 2048, kbase + 256, 2048, 4, 0, o, lsum);
    const float inv = 1.f / lsum;
    bf16_t* orow = OC + row * 256 + h * 64;
#pragma unroll
    for (int d = 0; d < 2; ++d)
#pragma unroll
        for (int g4 = 0; g4 < 4; ++g4) {
            u32x2 w; w.x = cvtpk(o[d][4 * g4] * inv, o[d][4 * g4 + 1] * inv); w.y = cvtpk(o[d][4 * g4 + 2] * inv, o[d][4 * g4 + 3] * inv);
            *(u32x2*)(orow + 32 * d + 8 * g4 + 4 * hi) = w;
        }
}

__device__ __forceinline__ void sb_wave_unit(LAS unsigned char* wl, const bf16_t* P, bf16_t* MIX, int b, int h, int blk, const float* gn_b) {
    int tid = threadIdx.x; asm volatile("" : "+v"(tid));
    const int lane = tid & 63, r32 = lane & 31, hi = lane >> 5;
    const size_t rowb = (size_t)b * SEQ;
    const bf16_t* Qrow = P + (rowb + 32 * blk + r32) * DIN + 1536 + h * 64;
    const bf16_t* Kb = P + rowb * DIN + 1792 + h * 64;
    const bf16_t* Vb = P + rowb * DIN + 2048 + h * 64;
    bf16x8 qf[4];
#pragma unroll
    for (int ks = 0; ks < 4; ++ks) qf[ks] = *(const bf16x8*)(Qrow + ks * 16 + hi * 8);
    f32x16 o[2];
    o[0] = (f32x16){0.f, 0.f, 0.f, 0.f, 0.f, 0.f, 0.f, 0.f, 0.f, 0.f, 0.f, 0.f, 0.f, 0.f, 0.f, 0.f}; o[1] = o[0];
    float C = 0.f;
    const int vlane = ((lane >> 4) & 1) * 32 + (lane & 3) * 8 + (4 * hi + ((lane & 15) >> 2)) * 64;
    for (int j = blk; j >= 0; --j) {
        const int key0 = 32 * j;
        bf16x8 kf[4]; u32x4 vv[4];
#pragma unroll
        for (int ks = 0; ks < 4; ++ks) kf[ks] = *(const bf16x8*)(Kb + (size_t)(key0 + r32) * DIN + ks * 16 + hi * 8);
#pragma unroll
        for (int p = 0; p < 4; ++p) vv[p] = *(const u32x4*)(Vb + (size_t)(key0 + 16 * (p & 1) + (lane >> 2)) * DIN + (p >> 1) * 32 + (lane & 3) * 8);
        f32x16 z = (f32x16){0.f, 0.f, 0.f, 0.f, 0.f, 0.f, 0.f, 0.f, 0.f, 0.f, 0.f, 0.f, 0.f, 0.f, 0.f, 0.f};
#pragma unroll
        for (int ks = 0; ks < 4; ++ks) z = mfma32(kf[ks], qf[ks], z);
#pragma unroll
        for (int p = 0; p < 4; ++p) *(LAS u32x4*)(wl + p * 1024 + lane * 16) = vv[p];
        const bool diag = (j == blk);
        float lk[16], lsg[16], gs[4], pg[4];
#pragma unroll
        for (int r = 0; r < 16; ++r) {
            const bool strict = !diag || (crow(r, hi) < r32);
            const float z2 = z[r] * LOG2E;
            const float sp = fmaxf(z2, 0.f) + lg2(1.f + ex2(-fabsf(z2)));
            lk[r] = strict ? -sp : 0.f;
            lsg[r] = strict ? (z2 - sp) : -INFINITY;
        }
#pragma unroll
        for (int g = 0; g < 4; ++g) { gs[g] = (lk[4 * g] + lk[4 * g + 1]) + (lk[4 * g + 2] + lk[4 * g + 3]); pg[g] = swap32(gs[g]); }
        float sfx[4];
        { float own = 0.f, par = 0.f;
#pragma unroll
          for (int g = 3; g >= 0; --g) { sfx[g] = C + own + par + ((hi == 0) ? pg[g] : 0.f); own += gs[g]; par += pg[g]; }
          C += own + par; }
        float w[16];
#pragma unroll
        for (int g = 0; g < 4; ++g) {
            float run = sfx[g];
#pragma unroll
            for (int e = 3; e >= 0; --e) { w[4 * g + e] = ex2(lsg[4 * g + e] + run); run += lk[4 * g + e]; }
        }
        bf16x8 pw[2];
        { u32x4 t;
          t.x = cvtpk(w[0], w[1]); t.y = cvtpk(w[2], w[3]); t.z = cvtpk(w[4], w[5]); t.w = cvtpk(w[6], w[7]); pw[0] = __builtin_bit_cast(bf16x8, t);
          t.x = cvtpk(w[8], w[9]); t.y = cvtpk(w[10], w[11]); t.z = cvtpk(w[12], w[13]); t.w = cvtpk(w[14], w[15]); pw[1] = __builtin_bit_cast(bf16x8, t); }
#pragma unroll
        for (int d = 0; d < 2; ++d)
#pragma unroll
            for (int ks = 0; ks < 2; ++ks) o[d] = mfma32(vfrag(wl + vlane + d * 2048 + ks * 1024), pw[ks], o[d]);
        if (__all(C < -160.f)) break;
    }
    float sq = 0.f;
#pragma unroll
    for (int d = 0; d < 2; ++d)
#pragma unroll
        for (int r = 0; r < 16; ++r) sq += o[d][r] * o[d][r];
    sq += swap32(sq);
    const float rs = __builtin_amdgcn_rsqf(sq * (1.f / 64.f) + EPS);
    bf16_t* orow = MIX + (rowb + 32 * blk + r32) * DM + 512 + h * 64;
#pragma unroll
    for (int d = 0; d < 2; ++d)
#pragma unroll
        for (int g4 = 0; g4 < 4; ++g4) {
            const int dd = 32 * d + 8 * g4 + 4 * hi;
            const f32x4 gn = *(const f32x4*)(gn_b + h * 64 + dd);
            u32x2 t; t.x = cvtpk(o[d][4 * g4] * rs * gn[0], o[d][4 * g4 + 1] * rs * gn[1]); t.y = cvtpk(o[d][4 * g4 + 2] * rs * gn[2], o[d][4 * g4 + 3] * rs * gn[3]);
            *(u32x2*)(orow + dd) = t;
        }
}

__device__ __forceinline__ void sgu_unit(LAS unsigned char* lds, const bf16_t* P, bf16_t* MIX, int b, int ch, int g, const float* sgn, const float* wsp, const float* bsp, const float* gno) {
    int tid = threadIdx.x; asm volatile("" : "+v"(tid));
    LAS float* Wl = (LAS float*)lds;
    LAS float* Vl = (LAS float*)(lds + 128 * 129 * 4);
    const size_t row0 = (size_t)b * SEQ + ch * 128;
    for (int i = tid; i < 128 * 128; i += NTHR) { const int t = i >> 7, s = i & 127; Wl[t * 129 + s] = (s <= t) ? wsp[(size_t)g * 16384 + i] : 0.f; }
    {
        const int t = tid >> 2, q = tid & 3;
        const bf16_t* vp = P + (row0 + t) * DIN + 2560 + g * 64 + q * 16;
        const u32x4 a = *(const u32x4*)vp, c = *(const u32x4*)(vp + 8);
        float v[16] = {bflo(a.x), bfhi(a.x), bflo(a.y), bfhi(a.y), bflo(a.z), bfhi(a.z), bflo(a.w), bfhi(a.w), bflo(c.x), bfhi(c.x), bflo(c.y), bfhi(c.y), bflo(c.z), bfhi(c.z), bflo(c.w), bfhi(c.w)};
        float sq = 0.f;
#pragma unroll
        for (int e = 0; e < 16; ++e) sq += v[e] * v[e];
        sq += __shfl_xor(sq, 1); sq += __shfl_xor(sq, 2);
        const float rs = __builtin_amdgcn_rsqf(sq * (1.f / 64.f) + EPS);
#pragma unroll
        for (int e = 0; e < 16; ++e) Vl[t * 64 + q * 16 + e] = v[e] * rs * sgn[g * 64 + q * 16 + e];
    }
    __syncthreads();
    const int ty = tid >> 4, tx = tid & 15;
    float acc[4][4];
#pragma unroll
    for (int i = 0; i < 4; ++i)
#pragma unroll
        for (int j = 0; j < 4; ++j) acc[i][j] = 0.f;
    for (int s = 0; s < 128; ++s) {
        const f32x4 vv = *(const LAS f32x4*)(Vl + s * 64 + tx * 4);
#pragma unroll
        for (int i = 0; i < 4; ++i) { const float w = Wl[(ty + 32 * i) * 129 + s];
#pragma unroll
            for (int j = 0; j < 4; ++j) acc[i][j] += w * vv[j]; }
    }
#pragma unroll
    for (int i = 0; i < 4; ++i) {
        const int t = ty + 32 * i;
        const float bias = bsp[g * 128 + t];
        const u32x2 uu = *(const u32x2*)(P + (row0 + t) * DIN + 2304 + g * 64 + tx * 4);
        float ov[4] = {bflo(uu.x) * (acc[i][0] + bias), bfhi(uu.x) * (acc[i][1] + bias), bflo(uu.y) * (acc[i][2] + bias), bfhi(uu.y) * (acc[i][3] + bias)};
        float sq = ov[0] * ov[0] + ov[1] * ov[1] + ov[2] * ov[2] + ov[3] * ov[3];
        sq += __shfl_xor(sq, 1); sq += __shfl_xor(sq, 2); sq += __shfl_xor(sq, 4); sq += __shfl_xor(sq, 8);
        const float rs = __builtin_amdgcn_rsqf(sq * (1.f / 64.f) + EPS);
        const f32x4 gn = *(const f32x4*)(gno + g * 64 + tx * 4);
        u32x2 w; w.x = cvtpk(ov[0] * rs * gn[0], ov[1] * rs * gn[1]); w.y = cvtpk(ov[2] * rs * gn[2], ov[3] * rs * gn[3]);
        *(u32x2*)(MIX + (row0 + t) * DM + 768 + g * 64 + tx * 4) = w;
    }
    __syncthreads();
}

__device__ __forceinline__ void transpose_item(const float* W, int N, const float* gain, bf16_t* WT, int ldt, int k0, int n0, LAS float* scr, int lane) {
    f32x4 v[16];
#pragma unroll
    for (int i = 0; i < 16; ++i) v[i] = *(const f32x4*)(W + (size_t)(k0 + 4 * i + (lane >> 4)) * N + n0 + (lane & 15) * 4);
#pragma unroll
    for (int i = 0; i < 16; ++i) {
        const int k = 4 * i + (lane >> 4);
        const float gk = gain ? gain[k0 + k] : 1.f;
#pragma unroll
        for (int e = 0; e < 4; ++e) scr[k * 65 + (lane & 15) * 4 + e] = v[i][e] * gk;
    }
    LDS_WAIT();
    const int kc = lane >> 3;
#pragma unroll
    for (int j = 0; j < 8; ++j) {
        const int n = 8 * j + (lane & 7);
        const LAS float* s = scr + (8 * kc) * 65 + n;
        u32x4 o; o.x = cvtpk(s[0], s[65]); o.y = cvtpk(s[2 * 65], s[3 * 65]); o.z = cvtpk(s[4 * 65], s[5 * 65]); o.w = cvtpk(s[6 * 65], s[7 * 65]);
        *(u32x4*)(WT + (size_t)(n0 + n) * ldt + k0 + 8 * kc) = o;
    }
    LDS_WAIT();
}

struct Args {
    const float* x; const float* mem; const int* pos; const float* norm_mix; const float* w_in; const float* lam_q1; const float* lam_k1; const float* lam_q2; const float* lam_k2;
    const float* subln_a; const float* norm_b_out; const float* sgu_norm; const float* w_spatial; const float* b_spatial; const float* norm_c_out; const float* w_out;
    const float* norm_cross; const float* norm_mem; const float* w_cq; const float* w_ck; const float* w_cv; const float* w_co; const float* norm_ffn;
    const float* w_group; const float* b_group; const float* w_router; const float* b_router; const float* w_gate; const float* w_up; const float* w_down; const float* norm_final;
    float* out; unsigned char* ws; int ph_lo, ph_hi;
};
constexpr int PH_PER_LAYER = 10, PH_LAYER0 = 2, PH_FINAL = PH_LAYER0 + DEPTH * PH_PER_LAYER, N_PHASES = PH_FINAL + 1;

typedef __attribute__((address_space(4))) const Args* KArgP;
__device__ __forceinline__ KArgP kargs() { KArgP p = (KArgP)__builtin_amdgcn_kernarg_segment_ptr(); asm volatile("" : "+s"(p)); return p; }
#define KA (kargs())
template <class T> __device__ __forceinline__ T* asg(T* p) { GAS T* q = (GAS T*)p; asm volatile("" : "+s"(q)); return (T*)q; }
__device__ __forceinline__ unsigned char* opq(unsigned char* p) { return asg(p); }
#define X ((float*)(opq(ws) + WS_X))
#define XB ((bf16_t*)(opq(ws) + WS_XB))
#define PROJ ((bf16_t*)(opq(ws) + WS_PROJ))
#define MIX ((bf16_t*)(opq(ws) + WS_MIX))
#define QC ((bf16_t*)(opq(ws) + WS_QC))
#define OC ((bf16_t*)(opq(ws) + WS_OC))
#define HS ((bf16_t*)(opq(ws) + WS_HS))
#define ACT ((bf16_t*)(opq(ws) + WS_ACT))
#define MEMBF ((bf16_t*)(opq(ws) + WS_MEMBF))
#define KVC ((bf16_t*)(opq(ws) + WS_KVC))
#define WIN ((bf16_t*)(opq(ws) + WS_WIN))
#define WOUT ((bf16_t*)(opq(ws) + WS_WOUT))
#define WCKV ((bf16_t*)(opq(ws) + WS_WCKV))
#define WCQ ((bf16_t*)(opq(ws) + WS_WCQ))
#define WCO ((bf16_t*)(opq(ws) + WS_WCO))
#define WGU ((bf16_t*)(opq(ws) + WS_WGU))
#define WD ((bf16_t*)(opq(ws) + WS_WD))
#define SS0 ((float*)(opq(ws) + WS_SS0))
#define SS1 ((float*)(opq(ws) + WS_SS1))
#define SSMEM ((float*)(opq(ws) + WS_SSMEM))
#define LAMV ((float*)(opq(ws) + WS_LAMV))
#define RSTD2 ((float*)(opq(ws) + WS_RSTD2))
#define CTOK ((int*)(opq(ws) + WS_CTOK))
#define CRS ((float*)(opq(ws) + WS_CRS))
#define CWT ((float*)(opq(ws) + WS_CWT))
#define ROT ((float*)(opq(ws) + WS_ROT))
#define SLOTTOK ((int*)(opq(ws) + WS_SLOTTOK))
#define SLOTW ((float*)(opq(ws) + WS_SLOTW))
__global__ void __launch_bounds__(NTHR, 2) fwd_kernel(Args a) {
    extern __shared__ __attribute__((aligned(16))) unsigned char lds_raw[];
    LAS unsigned char* lds = (LAS unsigned char*)lds_raw;
    volatile LAS unsigned* MISC = (volatile LAS unsigned*)(lds + MISC_OFF);
    const int tid = threadIdx.x, lane = tid & 63, wave = __builtin_amdgcn_readfirstlane(tid >> 6);
    const int G = gridDim.x, bx = blockIdx.x, vcu = (G % 8 == 0) ? (bx % 8) * (G / 8) + bx / 8 : bx;
    unsigned char* ws = a.ws;
    gu32* ctl = (gu32*)(ws + WS_CTL);
    for (int u = tid; u < (LDS_BYTES - MISC_OFF) / 4; u += NTHR) MISC[u] = 0u;
    __syncthreads();
    XcdBarrier bar; bar.bar = (unsigned*)ctl + CW_BAR; bar.x = 0; bar.st = nullptr;
    if (!MK_MULTI) bar = xcd_barrier_post((unsigned*)ctl + CW_BAR, MISC);
    const int lo = a.ph_lo, hi_ph = a.ph_hi;
#ifndef PHEN
#define PHEN 0xffff
#endif
#define EN(b) ((PHEN >> (b)) & 1)
#define IN(k) (lo <= (k) && (k) < hi_ph)
#define SEAM(k) do { if (!MK_MULTI && IN(k) && IN((k) + 1)) xcd_barrier(bar); } while (0)

    const int gw_ = vcu * NWAVES + wave, NGW = G * NWAVES;

    if (EN(0) && IN(0)) {
        int tid = threadIdx.x; asm volatile("" : "+v"(tid)); const int lane = tid & 63; int gw = gw_; asm volatile("" : "+s"(gw));
        LAS float* scr = (LAS float*)(lds + wave * 16640);
        constexpr int I_GU = 128 * 128, I_D = 64 * 128, I_IN = 4 * 16 * 44, I_OUT = 4 * 256, I_C3 = 12 * 64, I_CO = 4 * 64;
        constexpr int NITEMS = I_GU + I_D + I_IN + I_OUT + I_C3 + I_CO;
        for (int it = gw; it < NITEMS; it += NGW) {
            int r = it;
            if (r < I_GU) { const int mtx = r >> 7, t = r & 127, le = mtx >> 1, up = mtx & 1, kb = t >> 3, nb = t & 7;
                transpose_item((up ? asg(KA->w_up) : asg(KA->w_gate)) + (size_t)le * 1024 * 512, 512, asg(KA->norm_ffn) + (le >> 4) * 1024, WGU + ((size_t)le * 1024 + up * 512) * 1024, 1024, kb * 64, nb * 64, scr, lane); continue; }
            r -= I_GU;
            if (r < I_D) { const int le = r >> 7, t = r & 127, kb = t >> 4, nb = t & 15;
                transpose_item(asg(KA->w_down) + (size_t)le * 512 * 1024, 1024, nullptr, WD + (size_t)le * 1024 * 512, 512, kb * 64, nb * 64, scr, lane); continue; }
            r -= I_D;
            if (r < I_IN) { const int l = r / 704, t = r % 704, kb = t / 44, nb = t % 44;
                transpose_item(asg(KA->w_in) + (size_t)l * 1024 * DIN, DIN, asg(KA->norm_mix) + l * 1024, WIN + (size_t)l * DIN * 1024, 1024, kb * 64, nb * 64, scr, lane); continue; }
            r -= I_IN;
            if (r < I_OUT) { const int l = r >> 8, t = r & 255, kb = t >> 4, nb = t & 15;
                transpose_item(asg(KA->w_out) + (size_t)l * 1024 * 1024, 1024, nullptr, WOUT + (size_t)l * 1024 * 1024, 1024, kb * 64, nb * 64, scr, lane); continue; }
            r -= I_OUT;
            if (r < I_C3) { const int mtx = r >> 6, t = r & 63, l = mtx / 3, which = mtx % 3, kb = t >> 2, nb = t & 3;
                const float* src = (which == 0 ? asg(KA->w_ck) : which == 1 ? asg(KA->w_cv) : asg(KA->w_cq)) + (size_t)l * 1024 * 256;
                bf16_t* dst = (which == 2) ? WCQ + (size_t)l * 256 * 1024 : WCKV + ((size_t)l * 512 + which * 256) * 1024;
                transpose_item(src, 256, (which == 2 ? asg(KA->norm_cross) : asg(KA->norm_mem)) + l * 1024, dst, 1024, kb * 64, nb * 64, scr, lane); continue; }
            r -= I_C3;
            { const int l = r >> 6, t = r & 63, kb = t >> 4, nb = t & 15;
              transpose_item(asg(KA->w_co) + (size_t)l * 256 * 1024, 1024, nullptr, WCO + (size_t)l * 1024 * 256, 256, kb * 64, nb * 64, scr, lane); }
        }
        for (int m = gw; m < MTOK + MROWS; m += NGW) {
            const bool ismem = (m >= MTOK);
            const float* src = ismem ? asg(KA->mem) + (size_t)(m - MTOK) * DM : asg(KA->x) + (size_t)m * DM;
            bf16_t* dst = ismem ? MEMBF + (size_t)(m - MTOK) * DM : XB + (size_t)m * DM;
            float s = 0.f;
#pragma unroll
            for (int j = 0; j < 4; ++j) { const f32x4 v = *(const f32x4*)(src + j * 256 + lane * 4); s += v[0] * v[0] + v[1] * v[1] + v[2] * v[2] + v[3] * v[3];
                u32x2 w; w.x = cvtpk(v[0], v[1]); w.y = cvtpk(v[2], v[3]); *(u32x2*)(dst + j * 256 + lane * 4) = w; }
            s = wave_sum(s);
            if (ismem) { if (lane == 0) SSMEM[m - MTOK] = s; } else if (lane < 16) SS0[(size_t)m * 16 + lane] = (lane == 0) ? s : 0.f;
        }
        for (int i = bx * NTHR + tid; i < MTOK * 8; i += G * NTHR) {
            const int row = i >> 3, k = i & 7;
            const float invf = (float)exp2(-(double)k * (18.931568569324174 / 8.0));
            const float ang = (float)asg(KA->pos)[row] * invf;
            const double rev = (double)ang * 0.15915494309189535;
            const float fr = (float)(rev - floor(rev));
            ROT[(size_t)row * 16 + k] = __builtin_amdgcn_cosf(fr); ROT[(size_t)row * 16 + 8 + k] = __builtin_amdgcn_sinf(fr);
        }
        if (bx == 0 && wave == 0) {
            for (int l = 0; l < DEPTH; ++l) {
                const float s1 = wave_sum(asg(KA->lam_q1)[l * 64 + lane] * asg(KA->lam_k1)[l * 64 + lane]), s2 = wave_sum(asg(KA->lam_q2)[l * 64 + lane] * asg(KA->lam_k2)[l * 64 + lane]);
                const float lam_init = 0.8f - 0.6f * expf(-0.3f * (float)l);
                if (lane == 0) LAMV[l] = expf(s1) - expf(s2) + lam_init;
            }
        }
    }
    SEAM(0);
    if (EN(1) && IN(1)) {
        pg8::DenseOrder S; S.init(MEMBF, WCKV, DM, DM, MROWS, 2048, G, bx);
        pg8::GemmP g{DM, DM, DM, (size_t)128 * DM * 2, 1 << 20};
        EpiScale E{KVC, 2048, SSMEM, 1, 1.f};
        pg8::gemm_phase(lds, g, S, E);
    }
    SEAM(1);

#pragma unroll 1
    for (int l = 0; l < DEPTH; ++l) {
        const int p0 = PH_LAYER0 + l * PH_PER_LAYER;
        const float lam_init = 0.8f - 0.6f * expf(-0.3f * (float)l);
        if (EN(2) && IN(p0 + 0)) {
            pg8::DenseOrder S; S.init(XB, WIN + (size_t)l * DIN * DM, DM, DM, MTOK, DIN, G, bx);
            pg8::GemmP g{DM, DM, DM, (size_t)128 * DM * 2, 1 << 20};
            EpiInProj E{PROJ, SS0, ROT};
            pg8::gemm_phase(lds, g, S, E);
        }
        SEAM(p0 + 0);
        if (IN(p0 + 1)) {
            int gw = gw_; asm volatile("" : "+s"(gw));
            const float lam = LAMV[l];
            if (EN(12)) {
                const int j = vcu & 31, bh = 2 * (vcu >> 5) + (j >> 4), s = j & 15;
                if (G == 256) {
                    diff_unit(lds, PROJ, MIX, bh >> 2, bh & 3, 31 - s, lam, 1.f - lam_init, asg(KA->subln_a) + l * 128);
                    diff_unit(lds, PROJ, MIX, bh >> 2, bh & 3, s, lam, 1.f - lam_init, asg(KA->subln_a) + l * 128);
                } else {
                    for (int u = bx; u < 512; u += G) { const int bh2 = u >> 5; diff_unit(lds, PROJ, MIX, bh2 >> 2, bh2 & 3, u & 31, lam, 1.f - lam_init, asg(KA->subln_a) + l * 128); }
                }
            }
            if (EN(13)) for (int u = gw; u < 2048; u += NGW) { const int bh = u >> 7; sb_wave_unit(lds + wave * 4096, PROJ, MIX, bh >> 2, bh & 3, u & 127, asg(KA->norm_b_out) + l * 256); }
            __syncthreads();
            if (EN(14)) for (int u = bx; u < 512; u += G) { const int b = u >> 7, ch = (u >> 2) & 31, g = u & 3;
                sgu_unit(lds, PROJ, MIX, b, ch, g, asg(KA->sgu_norm) + l * 256, asg(KA->w_spatial) + (size_t)l * 4 * 16384, asg(KA->b_spatial) + l * 512, asg(KA->norm_c_out) + l * 256); }
        }
        SEAM(p0 + 1);
        if (EN(3) && IN(p0 + 2)) {
            pg8::DenseOrder S; S.init(MIX, WOUT + (size_t)l * DM * DM, DM, DM, MTOK, DM, G, bx);
            pg8::GemmP g{DM, DM, DM, (size_t)128 * DM * 2, 1 << 20};
            EpiResid E{l == 0 ? asg(KA->x) : X, X, XB, SS1, nullptr};
            pg8::gemm_phase(lds, g, S, E);
        }
        SEAM(p0 + 2);
        if (EN(4) && IN(p0 + 3)) {
            pg8::DenseOrder S; S.init(XB, WCQ + (size_t)l * 256 * DM, DM, DM, MTOK, 256, G, bx);
            pg8::GemmP g{DM, DM, DM, (size_t)128 * DM * 2, 1 << 20};
            EpiScale E{QC, 256, SS1, 16, 0.125f};
            pg8::gemm_phase(lds, g, S, E);
        }
        SEAM(p0 + 3);
        if (EN(5) && IN(p0 + 4)) {
            for (int u = bx; u < 256; u += G) cross_unit(lds, QC, KVC, OC, u >> 6, (u >> 4) & 3, u & 15, l);
        }
        SEAM(p0 + 4);
        if (EN(6) && IN(p0 + 5)) {
            pg8::DenseOrder S; S.init(OC, WCO + (size_t)l * DM * 256, 256, 256, MTOK, DM, G, bx);
            pg8::GemmP g{256, 256, 256, (size_t)128 * 256 * 2, 1 << 20};
            EpiResid E{X, X, XB, nullptr, nullptr};
            pg8::gemm_phase(lds, g, S, E);
        }
        SEAM(p0 + 5);
        if (EN(7) && IN(p0 + 6)) {
            int tid = threadIdx.x; asm volatile("" : "+v"(tid)); const int lane = tid & 63; int gw = gw_; asm volatile("" : "+s"(gw));
            LAS float* gW = (LAS float*)lds;
            for (int i = tid; i < 20 * 1024; i += NTHR) { const int j = i >> 10, k = i & 1023;
                const float w = (j < 4) ? asg(KA->w_group)[(size_t)l * 4096 + k * 4 + j] : asg(KA->w_router)[(size_t)l * 16384 + k * 16 + (j - 4)];
                gW[i] = w * asg(KA->norm_ffn)[l * 1024 + k]; }
            __syncthreads();
            LAS float* dl = (LAS float*)(lds + 20 * 1024 * 4) + wave * 32;
#pragma unroll 1
            for (int m = gw; m < MTOK; m += NGW) {
                float xv[16], s = 0.f, d[20];
#pragma unroll
                for (int i = 0; i < 16; ++i) { xv[i] = X[(size_t)m * DM + i * 64 + lane]; s += xv[i] * xv[i]; }
#pragma unroll 1
                for (int jg = 0; jg < 5; ++jg) {
                    float t0 = 0.f, t1 = 0.f, t2 = 0.f, t3 = 0.f;
                    const LAS float* gp = gW + jg * 4096 + lane;
#pragma unroll
                    for (int i = 0; i < 16; ++i) { t0 += xv[i] * gp[i * 64]; t1 += xv[i] * gp[1024 + i * 64]; t2 += xv[i] * gp[2048 + i * 64]; t3 += xv[i] * gp[3072 + i * 64]; }
                    t0 = wave_sum(t0); t1 = wave_sum(t1); t2 = wave_sum(t2); t3 = wave_sum(t3);
                    if (lane == 0) { dl[jg * 4] = t0; dl[jg * 4 + 1] = t1; dl[jg * 4 + 2] = t2; dl[jg * 4 + 3] = t3; }
                }
                s = wave_sum(s);
                LDS_WAIT();
#pragma unroll
                for (int j = 0; j < 20; ++j) d[j] = dl[j];
                const float rstd = 1.f / sqrtf(s * (1.f / DM) + EPS);
                float gl[4]; int gi = 0;
#pragma unroll
                for (int j = 0; j < 4; ++j) gl[j] = d[j] * rstd + asg(KA->b_group)[l * 4 + j];
                float gmax = gl[0];
#pragma unroll
                for (int j = 1; j < 4; ++j) if (gl[j] > gmax) { gmax = gl[j]; gi = j; }
                float den = 0.f;
#pragma unroll
                for (int j = 0; j < 4; ++j) den += expf(gl[j] - gmax);
                const float pgrp = 1.f / den;
                float el[4];
#pragma unroll
                for (int j = 0; j < 4; ++j) { float v = 0.f;
#pragma unroll
                    for (int q = 0; q < 4; ++q) v = (gi == q) ? d[4 + 4 * q + j] * rstd + asg(KA->b_router)[l * 16 + 4 * q + j] : v;
                    el[j] = v; }
                int i0 = 0, i1 = -1; float v0 = el[0], v1 = -INFINITY;
#pragma unroll
                for (int j = 1; j < 4; ++j) if (el[j] > v0) { v0 = el[j]; i0 = j; }
#pragma unroll
                for (int j = 0; j < 4; ++j) if (j != i0 && el[j] > v1) { v1 = el[j]; i1 = j; }
                const float e1 = expf(v1 - v0), w0 = pgrp / (1.f + e1), w1 = pgrp * e1 / (1.f + e1);
                const int elo = i0 < i1 ? i0 : i1, ehi = i0 < i1 ? i1 : i0;
                const float wlo = i0 < i1 ? w0 : w1, whi = i0 < i1 ? w1 : w0;
                const int pidx = (elo == 0) ? (ehi - 1) : (elo == 1 ? ehi + 1 : 5);
                const int bkt = gi * 6 + pidx;
                if (lane == 0) {
                    const unsigned pos = __hip_atomic_fetch_add((unsigned*)ctl + CW_CNT + 32 * l + bkt, 1u, __ATOMIC_RELAXED, __HIP_MEMORY_SCOPE_AGENT);
                    SLOTTOK[(size_t)bkt * SLOTCAP + pos] = m;
                    SLOTW[((size_t)bkt * SLOTCAP + pos) * 2] = wlo; SLOTW[((size_t)bkt * SLOTCAP + pos) * 2 + 1] = whi;
                    RSTD2[m] = rstd;
                }
            }
        }
        SEAM(p0 + 6);
        if (IN(p0 + 7) || IN(p0 + 8) || IN(p0 + 9)) {
            __syncthreads();
            if (tid == 0) { int acc = 0;
#pragma unroll 1
                for (int b = 0; b < NBUCKET; ++b) { MISC[16 + b] = (unsigned)acc;
                    const int nt_b = (int)((__hip_atomic_load((unsigned*)ctl + CW_CNT + 32 * l + b, __ATOMIC_RELAXED, __HIP_MEMORY_SCOPE_AGENT) + 255u) >> 8);
#pragma unroll 1
                    for (int q = 0; q < nt_b; ++q) MISC[48 + acc + q] = (unsigned)b;
                    acc += nt_b; }
                MISC[16 + NBUCKET] = (unsigned)acc; }
            __syncthreads();
        }
        const volatile LAS int* pre = (const volatile LAS int*)(MISC + 16);
        if (EN(8) && IN(p0 + 7)) {
            int tid = threadIdx.x; asm volatile("" : "+v"(tid)); const int lane = tid & 63; int gw = gw_; asm volatile("" : "+s"(gw));
            const int ncr = pre[NBUCKET] * 256;
            for (int cr = gw; cr < ncr; cr += NGW) {
                const int rt = cr >> 8;
                const int b = pre[32 + rt];
                const int idx = (rt - pre[b]) * 256 + (cr & 255);
                const int cnt = (int)__hip_atomic_load((unsigned*)ctl + CW_CNT + 32 * l + b, __ATOMIC_RELAXED, __HIP_MEMORY_SCOPE_AGENT);
                const bool valid = idx < cnt;
                const int tok = valid ? SLOTTOK[(size_t)b * SLOTCAP + idx] : -1;
                u32x4 v0 = (u32x4){0u, 0u, 0u, 0u}, v1 = v0;
                if (valid) { v0 = *(const u32x4*)(XB + (size_t)tok * DM + lane * 8); v1 = *(const u32x4*)(XB + (size_t)tok * DM + 512 + lane * 8); }
                *(u32x4*)(HS + (size_t)cr * DM + lane * 8) = v0; *(u32x4*)(HS + (size_t)cr * DM + 512 + lane * 8) = v1;
                if (lane == 0) { CTOK[cr] = tok; CRS[cr] = valid ? RSTD2[tok] : 0.f;
                    CWT[2 * cr] = valid ? SLOTW[((size_t)b * SLOTCAP + idx) * 2] : 0.f; CWT[2 * cr + 1] = valid ? SLOTW[((size_t)b * SLOTCAP + idx) * 2 + 1] : 0.f; }
            }
        }
        SEAM(p0 + 7);
        if (EN(9) && IN(p0 + 8)) {
            MoeOrder S{pre, (const char*)HS, (const char*)WGU, l, G, vcu, false};
            pg8::GemmP g{DM, DM, DM, (size_t)512 * DM * 2, 1 << 20};
            EpiG1 E{ACT, CRS, CWT};
            pg8::gemm_phase(lds, g, S, E);
        }
        SEAM(p0 + 8);
        if (EN(10) && IN(p0 + 9)) {
            MoeOrder S{pre, (const char*)ACT, (const char*)WD, l, G, vcu, true};
            pg8::GemmP g{DM, 512, DM, (size_t)128 * 512 * 2, 8};
            EpiResid E{X, X, XB, SS0, CTOK};
            pg8::gemm_phase(lds, g, S, E);
        }
        SEAM(p0 + 9);
    }
    if (EN(11) && IN(PH_FINAL)) {
        int tid = threadIdx.x; asm volatile("" : "+v"(tid)); const int lane = tid & 63; int gw = gw_; asm volatile("" : "+s"(gw));
        for (int m = gw; m < MTOK; m += NGW) {
            f32x4 v[4]; float sq = 0.f;
#pragma unroll
            for (int j = 0; j < 4; ++j) { v[j] = *(const f32x4*)(X + (size_t)m * DM + j * 256 + lane * 4); sq += v[j][0] * v[j][0] + v[j][1] * v[j][1] + v[j][2] * v[j][2] + v[j][3] * v[j][3]; }
            const float rs = 1.f / sqrtf(wave_sum(sq) * (1.f / DM) + EPS);
#pragma unroll
            for (int j = 0; j < 4; ++j) { const f32x4 gn = *(const f32x4*)(asg(KA->norm_final) + j * 256 + lane * 4);
                *(f32x4*)(asg(KA->out) + (size_t)m * DM + j * 256 + lane * 4) = v[j] * rs * gn; }
        }
    }
#undef IN
#undef SEAM
}
#undef X
#undef XB
#undef PROJ
#undef MIX
#undef QC
#undef OC
#undef HS
#undef ACT
#undef MEMBF
#undef KVC
#undef WIN
#undef WOUT
#undef WCKV
#undef WCQ
#undef WCO
#undef WGU
#undef WD
#undef SS0
#undef SS1
#undef SSMEM
#undef LAMV
#undef RSTD2
#undef CTOK
#undef CRS
#undef CWT
#undef ROT
#undef SLOTTOK
#undef SLOTW

extern "C" void kernel_launch(void* const* d_in, const int* in_sizes, int n_in, void* d_out, int out_size, void* d_ws, size_t ws_size, hipStream_t stream) {
    static int grid = 0;
    if (grid == 0) {
        if (n_in != 31 || in_sizes[0] != MTOK * DM || out_size != MTOK * DM || ws_size < WS_END) {
            fprintf(stderr, "kernel_launch: unexpected problem (n_in %d, in0 %d, out %d, ws %zu; need ws >= %zu); nothing launched\n", n_in, n_in > 0 ? in_sizes[0] : -1, out_size, ws_size, (size_t)WS_END); grid = -1; return; }
        int dev = 0, cus = 0, per_cu = 0;
        if (hipGetDevice(&dev) != hipSuccess || hipDeviceGetAttribute(&cus, hipDeviceAttributeMultiprocessorCount, dev) != hipSuccess) { grid = -1; return; }
        if (hipFuncSetAttribute((const void*)fwd_kernel, hipFuncAttributeMaxDynamicSharedMemorySize, LDS_BYTES) != hipSuccess) { fprintf(stderr, "kernel_launch: hipFuncSetAttribute failed\n"); grid = -1; return; }
        if (hipOccupancyMaxActiveBlocksPerMultiprocessor(&per_cu, (const void*)fwd_kernel, NTHR, LDS_BYTES) != hipSuccess || per_cu < 1) {
            fprintf(stderr, "kernel_launch: occupancy query reports %d workgroups per CU\n", per_cu); }
        (void)hipGetLastError();
        grid = cus;
    }
    if (grid < 0) return;
    if (hipMemsetAsync((char*)d_ws + WS_CTL, 0, CTL_ZERO_BYTES, stream) != hipSuccess) return;
    Args a{};
    const float** fp = (const float**)&a;
    for (int i = 0; i < 31; ++i) fp[i] = (const float*)d_in[i];
    a.out = (float*)d_out; a.ws = (unsigned char*)d_ws;
#if MK_MULTI
    for (int p = 0; p < N_PHASES; ++p) { a.ph_lo = p; a.ph_hi = p + 1; hipLaunchKernelGGL(fwd_kernel, dim3(grid), dim3(NTHR), LDS_BYTES, stream, a); }
#else
    a.ph_lo = 0; a.ph_hi = N_PHASES;
    hipLaunchKernelGGL(fwd_kernel, dim3(grid), dim3(NTHR), LDS_BYTES, stream, a);
#endif
}
```

```cpp
#include <hip/hip_runtime.h>
#include <cstdio>
#include <cstdint>

#ifndef MK_MULTI
#define MK_MULTI 0
#endif

#define LAS __attribute__((address_space(3)))
#define GAS __attribute__((address_space(1)))
typedef unsigned short bf16_t;
typedef short bf16x8 __attribute__((ext_vector_type(8)));
typedef short s16x4 __attribute__((ext_vector_type(4)));
typedef float f32x2 __attribute__((ext_vector_type(2)));
typedef float f32x4 __attribute__((ext_vector_type(4)));
typedef float f32x16 __attribute__((ext_vector_type(16)));
typedef unsigned u32x2 __attribute__((ext_vector_type(2)));
typedef unsigned u32x4 __attribute__((ext_vector_type(4)));
typedef __bf16 bf16x2_t __attribute__((ext_vector_type(2)));
typedef GAS unsigned gu32;

constexpr int NB = 4, SEQ = 4096, DM = 1024, MTOK = NB * SEQ, DEPTH = 4, DIN = 2816;
constexpr int MEML = 256, MROWS = NB * MEML;
constexpr int NBUCKET = 24, SLOTCAP = MTOK, MAXCROWS = 22528;
constexpr float EPS = 1e-6f, LOG2E = 1.4426950408889634f;
constexpr int NWAVES = 8, NTHR = 512;

constexpr size_t MiB = 1u << 20;
constexpr size_t WS_CTL = 0, CTL_ZERO_BYTES = 128 * 1024;
constexpr int CW_BAR = 4096;
constexpr int CW_CNT = 16384;
constexpr size_t WS_SS0 = 462 * MiB;
constexpr size_t WS_SS1 = 463 * MiB;
constexpr size_t WS_SSMEM = 2 * MiB;
constexpr size_t WS_LAMV = 2 * MiB + 4096;
constexpr size_t WS_RSTD2 = 2 * MiB + 65536;
constexpr size_t WS_CTOK = 2 * MiB + 131072;
constexpr size_t WS_CRS = 2 * MiB + 262144;
constexpr size_t WS_CWT = 2 * MiB + 393216;
constexpr size_t WS_ROT = 3 * MiB;
constexpr size_t WS_SLOTTOK = 4 * MiB;
constexpr size_t WS_SLOTW = 6 * MiB;
constexpr size_t WS_MEMBF = 10 * MiB;
constexpr size_t WS_KVC = 12 * MiB;
constexpr size_t WS_X = 16 * MiB;
constexpr size_t WS_XB = 80 * MiB;
constexpr size_t WS_PROJ = 112 * MiB;
constexpr size_t WS_HS = 112 * MiB, WS_ACT = 156 * MiB;
constexpr size_t WS_MIX = 200 * MiB;
constexpr size_t WS_QC = 200 * MiB, WS_OC = 208 * MiB;
constexpr size_t WS_WIN = 232 * MiB, WS_WOUT = 254 * MiB, WS_WCKV = 262 * MiB, WS_WCQ = 266 * MiB, WS_WCO = 268 * MiB, WS_WGU = 270 * MiB, WS_WD = 398 * MiB;
constexpr size_t WS_END = 464 * MiB;

constexpr int RING_BYTES = 131072, LDS_BYTES = 147456, MISC_OFF = LDS_BYTES - 1024;

__device__ __forceinline__ unsigned cvtpk(float lo, float hi) { f32x2 v = {lo, hi}; bf16x2_t b = __builtin_convertvector(v, bf16x2_t); return __builtin_bit_cast(unsigned, b); }
__device__ __forceinline__ float bf2f(unsigned short u) { return __builtin_bit_cast(float, (unsigned)u << 16); }
__device__ __forceinline__ float bflo(unsigned u) { return __builtin_bit_cast(float, u << 16); }
__device__ __forceinline__ float bfhi(unsigned u) { return __builtin_bit_cast(float, u & 0xffff0000u); }
__device__ __forceinline__ float ex2(float x) { return __builtin_amdgcn_exp2f(x); }
__device__ __forceinline__ float lg2(float x) { return __builtin_amdgcn_logf(x); }
__device__ __forceinline__ float wave_sum(float v) {
#pragma unroll
    for (int o = 1; o < 64; o <<= 1) v += __shfl_xor(v, o);
    return v;
}
__device__ __forceinline__ float swap32(float v) {
    auto rr = __builtin_amdgcn_permlane32_swap(__float_as_uint(v), __float_as_uint(v), false, false);
    return (threadIdx.x & 32) ? __uint_as_float(rr[0]) : __uint_as_float(rr[1]);
}
__device__ __forceinline__ int crow(int r, int hi) { return (r & 3) + 8 * (r >> 2) + 4 * hi; }
__device__ __forceinline__ float gelu_tanh(float x) {
    const float u = x * (0.7978845608028654f + 0.035677408136300125f * x * x);
    return x * __builtin_amdgcn_rcpf(1.f + ex2(-2.f * LOG2E * u));
}
__device__ __forceinline__ float sum16(const float* p) {
    const f32x4 a = *(const f32x4*)p, b = *(const f32x4*)(p + 4), c = *(const f32x4*)(p + 8), d = *(const f32x4*)(p + 12);
    return (((a[0] + a[1]) + (a[2] + a[3])) + ((b[0] + b[1]) + (b[2] + b[3]))) + (((c[0] + c[1]) + (c[2] + c[3])) + ((d[0] + d[1]) + (d[2] + d[3])));
}
#define VM_WAIT() asm volatile("s_waitcnt vmcnt(0)" ::: "memory")
#define LDS_WAIT() asm volatile("s_waitcnt lgkmcnt(0)" ::: "memory")

#define XB_TMO      128
#define XB_XCNT(j)  (256  + 64 * (j))
#define XB_XSUB(j)  (1280 + 64 * (j))
#define XB_XGEN(j)  (2304 + 64 * (j))
#define XB_TOP      3328
#define XB_TOPGEN   3392
#define XCD_BAR_WORDS 3456
#define XB_SPIN_CAP (1u << 18)
__device__ __forceinline__ unsigned xb_ld(unsigned* p)              { return __hip_atomic_load(p, __ATOMIC_RELAXED, __HIP_MEMORY_SCOPE_AGENT); }
__device__ __forceinline__ unsigned xb_add(unsigned* p, unsigned v) { return __hip_atomic_fetch_add(p, v, __ATOMIC_RELAXED, __HIP_MEMORY_SCOPE_AGENT); }
__device__ __forceinline__ unsigned xb_xcc_id() { return (unsigned)__builtin_amdgcn_s_getreg((3 << 11) | 20) & 0xFu; }
#define XB_SPIN(cond, bar) do { unsigned _sp = 0; while (cond) { __builtin_amdgcn_s_sleep(1); \
    if ((++_sp & 255u) == 0u) { if (xb_ld(&(bar)[XB_TMO])) break; if (_sp > XB_SPIN_CAP) { atomicAdd(&(bar)[XB_TMO], 1u); break; } } } } while (0)
struct XcdBarrier { unsigned* bar; unsigned x; volatile LAS unsigned* st; };
__device__ __forceinline__ XcdBarrier xcd_barrier_post(unsigned* bar, volatile LAS unsigned* st) {
    XcdBarrier b; b.bar = bar; b.x = xb_xcc_id(); b.st = st;
    if (threadIdx.x == 0) (void)xb_add(&bar[XB_XCNT(b.x)], 1u);
    return b;
}
__device__ __forceinline__ void xcd_barrier_complete(unsigned* bar, unsigned x, unsigned& nloc, unsigned& nx) {
    const unsigned G = gridDim.x * gridDim.y * gridDim.z;
    unsigned sum, cnt, mine, sp = 0u;
    for (;;) {
        sum = 0u; cnt = 0u; mine = 0u;
#pragma unroll
        for (unsigned j = 0; j < 16; ++j) { const unsigned c = xb_ld(&bar[XB_XCNT(j)]); sum += c; cnt += (c > 0u) ? 1u : 0u; mine = (j == x) ? c : mine; }
        if (sum == G) break;
        __builtin_amdgcn_s_sleep(1);
        if ((++sp & 255u) == 0u) { if (xb_ld(&bar[XB_TMO])) break; if (sp > XB_SPIN_CAP) { atomicAdd(&bar[XB_TMO], 1u); break; } }
    }
    nloc = mine > 0u ? mine : 1u; nx = cnt > 0u ? cnt : 1u;
}
__device__ __forceinline__ void xcd_barrier(const XcdBarrier& b) {
    asm volatile("s_waitcnt vmcnt(0)" ::: "memory");
    __syncthreads();
    if (threadIdx.x == 0) {
        unsigned* bar = b.bar;
        __builtin_amdgcn_s_waitcnt(0);
        unsigned nloc = b.st[0], nx = b.st[1];
        if (nloc == 0u) { xcd_barrier_complete(bar, b.x, nloc, nx); b.st[0] = nloc; b.st[1] = nx; }
        const unsigned old = xb_add(&bar[XB_XSUB(b.x)], 1u);
        const unsigned gen = old / nloc;
        if (old + 1u == (gen + 1u) * nloc) {
            __builtin_amdgcn_fence(__ATOMIC_RELEASE, "agent");
            asm volatile("s_waitcnt vmcnt(0)" ::: "memory");
            const unsigned og = xb_add(&bar[XB_TOP], 1u);
            const unsigned tg = og / nx;
            if (og + 1u == (tg + 1u) * nx) xb_add(&bar[XB_TOPGEN], 1u);
            else XB_SPIN(xb_ld(&bar[XB_TOPGEN]) == tg, bar);
            __builtin_amdgcn_fence(__ATOMIC_ACQUIRE, "agent");
            xb_add(&bar[XB_XGEN(b.x)], 1u);
            asm volatile("s_waitcnt vmcnt(0)" ::: "memory");
        } else {
            XB_SPIN(xb_ld(&bar[XB_XGEN(b.x)]) == gen, bar);
            __builtin_amdgcn_fence(__ATOMIC_ACQUIRE, "agent");
            asm volatile("s_waitcnt vmcnt(0)" ::: "memory");
        }
    }
    __syncthreads();
}

namespace pg8 {
constexpr int BM = 256, BK = 64, HALF = 128, HTB = HALF * BK * 2, NXCD = 8, WGM = 8;
__host__ __device__ __forceinline__ int lds_byte(int r, int c) { const int st = (r >> 4) * 2 + (c >> 5), rr = r & 15, cc = c & 31, ob = rr * 64 + cc * 2; return st * 1024 + (ob ^ (((ob >> 9) & 1) << 5)); }
__host__ __device__ __forceinline__ void stage_rc(int b, int& R, int& C) { const int st = b / 1024, sb = b % 1024, swz = sb ^ (((sb >> 9) & 1) << 5); R = (st >> 1) * 16 + swz / 64; C = (st & 1) * 32 + (swz % 64) / 2; }
__host__ __device__ __forceinline__ int perm32(int rho) { const int n = rho >> 4, i = rho & 15; return 8 * (i >> 2) + 4 * n + (i & 3); }

struct Unit { const char* A; const char* B; const char* B2; int pm, pn, aux; };
struct GemmP { int lda, ldb, K; size_t hstepB; int ksw; };

struct DenseOrder {
    const char* A; const char* Bt; int lda, ldb, nM, nN, nwg, G, c;
    __device__ void init(const void* A_, const void* Bt_, int lda_, int ldb_, int M, int N, int G_, int c_) { A = (const char*)A_; Bt = (const char*)Bt_; lda = lda_; ldb = ldb_; nM = M / BM; nN = N / BM; nwg = nM * nN; G = G_; c = c_; }
    __device__ bool next(int i, Unit& u) const {
        const long L = (long)i * G + c; if (L >= nwg) return false;
        int wgid = (int)L; { const int q = nwg / NXCD, r = nwg % NXCD, xcd = wgid % NXCD, off = wgid / NXCD; wgid = (xcd < r ? xcd * (q + 1) : r * (q + 1) + (xcd - r) * q) + off; }
        const int nig = WGM * nN, gid = wgid / nig, fm = gid * WGM, gsz = (nM - fm) < WGM ? (nM - fm) : WGM;
        u.pm = fm + ((wgid % nig) % gsz); u.pn = (wgid % nig) / gsz; u.aux = 0;
        u.A = A + (size_t)u.pm * BM * lda * 2; u.B = Bt + (size_t)u.pn * BM * ldb * 2; u.B2 = u.B; return true;
    }
};

template <class Epi, class Sched>
__device__ __forceinline__ void gemm_phase(LAS unsigned char* lds, const GemmP g, const Sched& S, const Epi& E) {
    int tid = threadIdx.x; asm volatile("" : "+v"(tid));
    const int wid = __builtin_amdgcn_readfirstlane(tid >> 6), lane = tid & 63, wr = wid >> 2, wc = wid & 3, fr = lane & 15, fq = lane >> 4;
    const int K = g.K, nt = K / BK, ksw = g.ksw;
    unsigned voffA[2], voffB[2];
#pragma unroll
    for (int i = 0; i < 2; ++i) { int R, C; stage_rc(tid * 16 + i * 8192, R, C); const int Rb = (R & ~31) + perm32(R & 31);
        voffA[i] = (unsigned)(R * g.lda + C) * 2u; voffB[i] = (unsigned)(Rb * g.ldb + C) * 2u; }
    const size_t kstep = (size_t)(BK * 2);
    const size_t hstepA = (size_t)HALF * g.lda * 2, hstepB = g.hstepB;
    const unsigned ldsw = (unsigned)wid * 1024u;
    const int aoff = lds_byte(wr * 64 + fr, fq * 8), boff = lds_byte(wc * 32 + fr, fq * 8);
#define PG8_SA(b, h) (((b) * 2 + (h)) * HTB)
#define PG8_SB(b, h) ((4 + (b) * 2 + (h)) * HTB)
#define PG8_STAGE(bufoff, gbase, voff) do { _Pragma("unroll") for (int _i = 0; _i < 2; ++_i) \
        __builtin_amdgcn_global_load_lds((const unsigned*)((const char*)(gbase) + (voff)[_i]), (LAS unsigned*)(lds + (bufoff) + ldsw + _i * 8192), 16, 0, 0); } while (0)
#define PG8_LDA(dst, b, h) do { _Pragma("unroll") for (int m = 0; m < 4; ++m) _Pragma("unroll") for (int k = 0; k < 2; ++k) dst[m][k] = *(const LAS bf16x8*)(lds + PG8_SA(b, h) + aoff + m * 2048 + k * 1024); } while (0)
#define PG8_LDB(dst, b, h) do { _Pragma("unroll") for (int n = 0; n < 2; ++n) _Pragma("unroll") for (int k = 0; k < 2; ++k) dst[n][k] = *(const LAS bf16x8*)(lds + PG8_SB(b, h) + boff + n * 2048 + k * 1024); } while (0)
#define PG8_MMA(ai, bj, At, Bt) do { __builtin_amdgcn_s_setprio(1); _Pragma("unroll") for (int m = 0; m < 4; ++m) _Pragma("unroll") for (int n = 0; n < 2; ++n) _Pragma("unroll") for (int k = 0; k < 2; ++k) \
        acc[ai][bj][m][n] = __builtin_amdgcn_mfma_f32_16x16x32_bf16(Bt[n][k], At[m][k], acc[ai][bj][m][n], 0, 0, 0); __builtin_amdgcn_s_setprio(0); } while (0)
#define PG8_WAIT_V(n) asm volatile("s_waitcnt vmcnt(" #n ")" ::: "memory")
#define PG8_WAIT_L(n) asm volatile("s_waitcnt lgkmcnt(" #n ")" ::: "memory")
#define PG8_BAR __builtin_amdgcn_s_barrier()
#define PG8_SCHED __builtin_amdgcn_sched_barrier(0)
    Unit cur, nxt; int ui = 0;
    if (!S.next(0, cur)) return;
    f32x4 acc[2][2][4][2];
#pragma unroll
    for (int a = 0; a < 2; ++a)
#pragma unroll
        for (int b = 0; b < 2; ++b)
#pragma unroll
            for (int m = 0; m < 4; ++m)
#pragma unroll
                for (int n = 0; n < 2; ++n) acc[a][b][m][n] = (f32x4){0.f, 0.f, 0.f, 0.f};
    bf16x8 At[4][2], B0[2][2], B1[2][2];
    const char* cA = cur.A; const char* cB = cur.B; const char* cB2 = cur.B2;
    PG8_STAGE(PG8_SB(0, 0), cB, voffB); PG8_STAGE(PG8_SB(0, 1), cB + hstepB, voffB); PG8_STAGE(PG8_SA(0, 0), cA, voffA); PG8_STAGE(PG8_SA(0, 1), cA + hstepA, voffA);
    if (wr == 1) PG8_BAR;
    PG8_WAIT_V(2); PG8_BAR;
    PG8_STAGE(PG8_SB(1, 0), cB + kstep, voffB); PG8_STAGE(PG8_SA(1, 0), cA + kstep, voffA); PG8_STAGE(PG8_SB(1, 1), cB + hstepB + kstep, voffB);
    PG8_WAIT_V(6); PG8_BAR;
    for (;;) {
        const bool has_next = S.next(ui + 1, nxt);
        const char* nA = has_next ? nxt.A : cA; const char* nB = has_next ? nxt.B : cB;
#pragma unroll 1
        for (int t = 0; t < nt; t += 2) {
            const bool last = (t == nt - 2);
            const char* a1 = cA + (size_t)(t + 1) * kstep;
            const char* a2 = last ? nA : cA + (size_t)(t + 2) * kstep;
            const char* b2 = last ? nB : ((t + 2 < ksw) ? cB : cB2) + (size_t)(t + 2) * kstep;
            const char* a3 = a2 + kstep; const char* b3 = b2 + kstep;
            PG8_LDB(B0, 0, 0); PG8_LDB(B1, 0, 1); PG8_SCHED; PG8_LDA(At, 0, 0); PG8_STAGE(PG8_SA(1, 1), a1 + hstepA, voffA);
            PG8_WAIT_V(8); PG8_WAIT_L(0); PG8_BAR; PG8_MMA(0, 0, At, B0); PG8_MMA(0, 1, At, B1); PG8_BAR; PG8_SCHED;
            PG8_LDA(At, 0, 1); PG8_STAGE(PG8_SB(0, 0), b2, voffB); PG8_STAGE(PG8_SB(0, 1), b2 + hstepB, voffB); PG8_STAGE(PG8_SA(0, 0), a2, voffA);
            PG8_WAIT_V(8); PG8_WAIT_L(0); PG8_BAR; PG8_MMA(1, 0, At, B0); PG8_MMA(1, 1, At, B1); PG8_BAR; PG8_SCHED;
            PG8_LDB(B0, 1, 0); PG8_LDB(B1, 1, 1); PG8_SCHED; PG8_LDA(At, 1, 0); PG8_STAGE(PG8_SA(0, 1), a2 + hstepA, voffA);
            PG8_WAIT_V(8); PG8_WAIT_L(0); PG8_BAR; PG8_MMA(0, 0, At, B0); PG8_MMA(0, 1, At, B1); PG8_BAR; PG8_SCHED;
            PG8_LDA(At, 1, 1); PG8_STAGE(PG8_SB(1, 0), b3, voffB); PG8_STAGE(PG8_SB(1, 1), b3 + hstepB, voffB); PG8_STAGE(PG8_SA(1, 0), a3, voffA);
            PG8_WAIT_V(8); PG8_WAIT_L(0); PG8_BAR; PG8_MMA(1, 0, At, B0); PG8_MMA(1, 1, At, B1); PG8_BAR; PG8_SCHED;
        }
        if (wr == 0) PG8_BAR;
        E(acc, cur, wr, wc, fr, fq);
        if (!has_next) break;
#pragma unroll
        for (int a = 0; a < 2; ++a)
#pragma unroll
            for (int b = 0; b < 2; ++b)
#pragma unroll
                for (int m = 0; m < 4; ++m)
#pragma unroll
                    for (int n = 0; n < 2; ++n) acc[a][b][m][n] = (f32x4){0.f, 0.f, 0.f, 0.f};
        cur = nxt; cA = nA; cB = nB; cB2 = nxt.B2; ++ui;
        if (wr == 1) PG8_BAR;
    }
    PG8_WAIT_V(0);
    PG8_BAR;
#undef PG8_SA
#undef PG8_SB
#undef PG8_STAGE
#undef PG8_LDA
#undef PG8_LDB
#undef PG8_MMA
#undef PG8_WAIT_V
#undef PG8_WAIT_L
#undef PG8_BAR
#undef PG8_SCHED
}
}
typedef f32x4 Acc[2][2][4][2];

struct EpiInProj {
    bf16_t* P; const float* ss; const float* rot;
    __device__ __forceinline__ void operator()(const Acc& acc, const pg8::Unit& u, int wr, int wc, int fr, int fq) const {
        const int pn = u.pn;
        const float qs = (pn < 2 || pn == 6) ? 0.125f : 1.f;
        const bool rotary = (pn < 4) && ((wc & 1) == 0);
        const bool gelu = (pn >= 9);
#pragma unroll
        for (int ai = 0; ai < 2; ++ai)
#pragma unroll
            for (int m = 0; m < 4; ++m) {
                const int row = u.pm * 256 + ai * 128 + wr * 64 + m * 16 + fr;
                const float rs = __builtin_amdgcn_rsqf(sum16(ss + (size_t)row * 16) * (1.f / DM) + EPS) * qs;
                f32x4 cs[4];
                if (rotary) {
#pragma unroll
                    for (int j = 0; j < 4; ++j) cs[j] = *(const f32x4*)(rot + (size_t)row * 16 + 4 * j);
                }
#pragma unroll
                for (int bj = 0; bj < 2; ++bj) {
                    float v[8];
#pragma unroll
                    for (int e = 0; e < 4; ++e) { v[e] = acc[ai][bj][m][0][e] * rs; v[4 + e] = acc[ai][bj][m][1][e] * rs; }
                    if (rotary) {
#pragma unroll
                        for (int e = 0; e < 8; ++e) {
                            const float p = __shfl_xor(v[e], 16);
                            const float c = cs[e >> 2][e & 3], s = cs[2 + (e >> 2)][e & 3];
                            const float r0 = v[e] * c - p * s, r1 = v[e] * c + p * s;
                            v[e] = (fq == 0) ? r0 : ((fq == 1) ? r1 : v[e]);
                        }
                    }
                    if (gelu) {
#pragma unroll
                        for (int e = 0; e < 8; ++e) v[e] = gelu_tanh(v[e]);
                    }
                    u32x4 w; w.x = cvtpk(v[0], v[1]); w.y = cvtpk(v[2], v[3]); w.z = cvtpk(v[4], v[5]); w.w = cvtpk(v[6], v[7]);
                    *(u32x4*)(P + (size_t)row * DIN + pn * 256 + bj * 128 + wc * 32 + fq * 8) = w;
                }
            }
    }
};
struct EpiScale {
    bf16_t* O; int ldc; const float* ss; int nss; float scale;
    __device__ __forceinline__ void operator()(const Acc& acc, const pg8::Unit& u, int wr, int wc, int fr, int fq) const {
#pragma unroll
        for (int ai = 0; ai < 2; ++ai)
#pragma unroll
            for (int m = 0; m < 4; ++m) {
                const int row = u.pm * 256 + ai * 128 + wr * 64 + m * 16 + fr;
                const float rs = __builtin_amdgcn_rsqf((nss == 16 ? sum16(ss + (size_t)row * 16) : ss[row]) * (1.f / DM) + EPS) * scale;
#pragma unroll
                for (int bj = 0; bj < 2; ++bj) {
                    const f32x4 a = acc[ai][bj][m][0] * rs, b = acc[ai][bj][m][1] * rs;
                    u32x4 w; w.x = cvtpk(a[0], a[1]); w.y = cvtpk(a[2], a[3]); w.z = cvtpk(b[0], b[1]); w.w = cvtpk(b[2], b[3]);
                    *(u32x4*)(O + (size_t)row * ldc + u.pn * 256 + bj * 128 + wc * 32 + fq * 8) = w;
                }
            }
    }
};
struct EpiResid {
    const float* Xi; float* Xo; bf16_t* XB; float* ssout; const int* rowmap;
    __device__ __forceinline__ void operator()(const Acc& acc, const pg8::Unit& u, int wr, int wc, int fr, int fq) const {
#pragma unroll
        for (int ai = 0; ai < 2; ++ai)
#pragma unroll
            for (int m = 0; m < 4; ++m) {
                const int r = ai * 128 + wr * 64 + m * 16 + fr;
                int row = u.pm * 256 + r;
                if (rowmap) row = rowmap[u.aux + r];
                float sq = 0.f;
                if (row >= 0) {
#pragma unroll
                    for (int bj = 0; bj < 2; ++bj) {
                        const size_t o = (size_t)row * DM + u.pn * 256 + bj * 128 + wc * 32 + fq * 8;
                        f32x4 a = *(const f32x4*)(Xi + o), b = *(const f32x4*)(Xi + o + 4);
                        a += acc[ai][bj][m][0]; b += acc[ai][bj][m][1];
                        *(f32x4*)(Xo + o) = a; *(f32x4*)(Xo + o + 4) = b;
                        sq += a[0] * a[0] + a[1] * a[1] + a[2] * a[2] + a[3] * a[3] + b[0] * b[0] + b[1] * b[1] + b[2] * b[2] + b[3] * b[3];
                        u32x4 w; w.x = cvtpk(a[0], a[1]); w.y = cvtpk(a[2], a[3]); w.z = cvtpk(b[0], b[1]); w.w = cvtpk(b[2], b[3]);
                        *(u32x4*)(XB + o) = w;
                    }
                }
                sq += __shfl_xor(sq, 16); sq += __shfl_xor(sq, 32);
                if (fq == 0 && row >= 0 && ssout) ssout[(size_t)row * 16 + u.pn * 4 + wc] = sq;
            }
    }
};
struct EpiG1 {
    bf16_t* ACT; const float* crs; const float* cwt;
    __device__ __forceinline__ void operator()(const Acc& acc, const pg8::Unit& u, int wr, int wc, int fr, int fq) const {
        const int sel = u.pn >> 2, ch = u.pn & 3;
#pragma unroll
        for (int ai = 0; ai < 2; ++ai)
#pragma unroll
            for (int m = 0; m < 4; ++m) {
                const int cr = u.aux + ai * 128 + wr * 64 + m * 16 + fr;
                const float rs = crs[cr], wt = cwt[2 * cr + sel];
                float v[8];
#pragma unroll
                for (int n = 0; n < 2; ++n)
#pragma unroll
                    for (int e = 0; e < 4; ++e) {
                        const float gg = acc[ai][0][m][n][e] * rs, uu = acc[ai][1][m][n][e] * rs;
                        v[4 * n + e] = gg * __builtin_amdgcn_rcpf(1.f + ex2(-LOG2E * gg)) * uu * wt;
                    }
                u32x4 w; w.x = cvtpk(v[0], v[1]); w.y = cvtpk(v[2], v[3]); w.z = cvtpk(v[4], v[5]); w.w = cvtpk(v[6], v[7]);
                *(u32x4*)(ACT + (size_t)cr * DM + sel * 512 + ch * 128 + wc * 32 + fq * 8) = w;
            }
    }
};

__device__ __forceinline__ void bucket_experts(int b, int& elo, int& ehi) {
    const int grp = b / 6, p = b % 6;
    const int lo = p < 3 ? 0 : (p < 5 ? 1 : 2), hi = p < 3 ? p + 1 : (p < 5 ? p - 1 : 3);
    elo = grp * 4 + lo; ehi = grp * 4 + hi;
}
struct MoeOrder {
    const volatile LAS int* pre; const char* A; const char* W; int layer, G, vcu; bool g2;
    __device__ bool next(int i, pg8::Unit& u) const {
        const int ncol = g2 ? 4 : 8;
        const long L = (long)i * G + vcu; if (L >= (long)pre[NBUCKET] * ncol) return false;
        const int rt = (int)(L / ncol), pn = (int)(L % ncol);
        const int b = pre[32 + rt];
        int elo, ehi; bucket_experts(b, elo, ehi);
        u.pm = rt; u.pn = pn; u.aux = rt * 256;
        u.A = A + (size_t)rt * 256 * DM * 2;
        if (!g2) { const int e = (pn < 4) ? elo : ehi; u.B = W + ((size_t)(layer * 16 + e) * 1024 + (pn & 3) * 128) * DM * 2; u.B2 = u.B; }
        else { u.B = W + ((size_t)(layer * 16 + elo) * 1024 + pn * 256) * 512 * 2; u.B2 = W + ((size_t)(layer * 16 + ehi) * 1024 + pn * 256) * 512 * 2 - 8 * 128; }
        return true;
    }
};

__device__ __forceinline__ f32x16 mfma32(bf16x8 a, bf16x8 b, f32x16 c) { return __builtin_amdgcn_mfma_f32_32x32x16_bf16(a, b, c, 0, 0, 0); }
typedef short v4i16_t __attribute__((ext_vector_type(4)));
__device__ __forceinline__ s16x4 vtr(const LAS unsigned char* p) { return __builtin_bit_cast(s16x4, __builtin_amdgcn_ds_read_tr16_b64_v4i16((LAS v4i16_t*)p)); }
__device__ __forceinline__ bf16x8 vfrag(const LAS unsigned char* p) { const s16x4 lo = vtr(p), hi = vtr(p + 512); return (bf16x8){lo[0], lo[1], lo[2], lo[3], hi[0], hi[1], hi[2], hi[3]}; }

template <int NMAP, int VD, bool CAUSAL>
__device__ __forceinline__ void flash_sweep(LAS unsigned char* lds, const bf16_t* Qrow, const bf16_t* Kbase, int kpitch, const bf16_t* Vbase, int vpitch, int NT, int q0w,
                                            f32x16 (&o)[VD / 32], float& lsum) {
    constexpr int NDB = VD / 32, KB = NMAP * 8192, BUF = KB + NDB * 4096, PPW = (NMAP * 8 + NDB * 4) / 8;
    int tid = threadIdx.x; asm volatile("" : "+v"(tid));
    const int lane = tid & 63, r32 = lane & 31, hi = lane >> 5, wid = __builtin_amdgcn_readfirstlane(tid >> 6);
    const int map = (NMAP == 2) ? (wid >> 2) : 0;
    bf16x8 qf[4];
#pragma unroll
    for (int ks = 0; ks < 4; ++ks) qf[ks] = *(const bf16x8*)(Qrow + ks * 16 + hi * 8);
#pragma unroll
    for (int d = 0; d < NDB; ++d) o[d] = (f32x16){0.f, 0.f, 0.f, 0.f, 0.f, 0.f, 0.f, 0.f, 0.f, 0.f, 0.f, 0.f, 0.f, 0.f, 0.f, 0.f};
    float mrow = -INFINITY; lsum = 0.f;
    auto issue = [&](int t, int buf) {
#pragma unroll
        for (int i = 0; i < PPW; ++i) {
            const int p = wid * PPW + i;
            const bf16_t* src;
            if (p < NMAP * 8) src = Kbase + (size_t)(64 * t + lane) * kpitch + (p >> 3) * 64 + (p & 7) * 8;
            else { const int pv = p - NMAP * 8; src = Vbase + (size_t)(64 * t + 16 * (pv & 3) + (lane >> 2)) * vpitch + (pv >> 2) * 32 + (lane & 3) * 8; }
            __builtin_amdgcn_global_load_lds((const unsigned*)src, (LAS unsigned*)(lds + buf * BUF + p * 1024), 16, 0, 0);
        }
    };
    const int vlane = ((lane >> 4) & 1) * 32 + (lane & 3) * 8 + (4 * hi + ((lane & 15) >> 2)) * 64;
    issue(0, 0);
    for (int t = 0; t < NT; ++t) {
        VM_WAIT(); __syncthreads();
        if (t + 1 < NT) issue(t + 1, (t + 1) & 1);
        if (CAUSAL && 64 * t > q0w + 31) continue;
        const LAS unsigned char* kb = lds + (t & 1) * BUF + map * 8192 + hi * 1024 + r32 * 16;
        const LAS unsigned char* vb = lds + (t & 1) * BUF + KB + vlane;
        f32x16 p0 = (f32x16){0.f, 0.f, 0.f, 0.f, 0.f, 0.f, 0.f, 0.f, 0.f, 0.f, 0.f, 0.f, 0.f, 0.f, 0.f, 0.f}, p1 = p0;
#pragma unroll
        for (int ks = 0; ks < 4; ++ks) {
            const bf16x8 k0 = *(const LAS bf16x8*)(kb + ks * 2048), k1 = *(const LAS bf16x8*)(kb + ks * 2048 + 512);
            p0 = mfma32(k0, qf[ks], p0); p1 = mfma32(k1, qf[ks], p1);
        }
        if (CAUSAL && 64 * t + 63 > q0w) {
            const int qq = q0w + r32 - 64 * t;
#pragma unroll
            for (int r = 0; r < 16; ++r) { const int kv = crow(r, hi); if (kv > qq) p0[r] = -INFINITY; if (kv + 32 > qq) p1[r] = -INFINITY; }
        }
        float rm = fmaxf(p0[0], p1[0]);
#pragma unroll
        for (int r = 1; r < 16; ++r) rm = fmaxf(rm, fmaxf(p0[r], p1[r]));
        rm = fmaxf(rm, swap32(rm));
        const float mnew = fmaxf(mrow, rm);
        if (__any(mnew > mrow)) {
            const float alpha = ex2((mrow - mnew) * LOG2E);
            lsum *= alpha;
#pragma unroll
            for (int d = 0; d < NDB; ++d)
#pragma unroll
                for (int r = 0; r < 16; ++r) o[d][r] *= alpha;
            mrow = mnew;
        }
        const float mc = mrow * LOG2E;
        float ls = 0.f;
#pragma unroll
        for (int r = 0; r < 16; ++r) { p0[r] = ex2(p0[r] * LOG2E - mc); p1[r] = ex2(p1[r] * LOG2E - mc); ls += p0[r] + p1[r]; }
        lsum += ls;
        bf16x8 pw[4];
        { u32x4 w;
          w.x = cvtpk(p0[0], p0[1]); w.y = cvtpk(p0[2], p0[3]); w.z = cvtpk(p0[4], p0[5]); w.w = cvtpk(p0[6], p0[7]); pw[0] = __builtin_bit_cast(bf16x8, w);
          w.x = cvtpk(p0[8], p0[9]); w.y = cvtpk(p0[10], p0[11]); w.z = cvtpk(p0[12], p0[13]); w.w = cvtpk(p0[14], p0[15]); pw[1] = __builtin_bit_cast(bf16x8, w);
          w.x = cvtpk(p1[0], p1[1]); w.y = cvtpk(p1[2], p1[3]); w.z = cvtpk(p1[4], p1[5]); w.w = cvtpk(p1[6], p1[7]); pw[2] = __builtin_bit_cast(bf16x8, w);
          w.x = cvtpk(p1[8], p1[9]); w.y = cvtpk(p1[10], p1[11]); w.z = cvtpk(p1[12], p1[13]); w.w = cvtpk(p1[14], p1[15]); pw[3] = __builtin_bit_cast(bf16x8, w); }
#pragma unroll
        for (int d = 0; d < NDB; ++d)
#pragma unroll
            for (int ks = 0; ks < 4; ++ks) o[d] = mfma32(vfrag(vb + d * 4096 + ks * 1024), pw[ks], o[d]);
    }
    lsum += swap32(lsum);
    __syncthreads();
}

__device__ __forceinline__ void diff_unit(LAS unsigned char* lds, const bf16_t* P, bf16_t* MIX, int b, int h, int qb, float lam, float oscale, const float* subln) {
    int tid = threadIdx.x; asm volatile("" : "+v"(tid));
    const int lane = tid & 63, r32 = lane & 31, hi = lane >> 5, wid = __builtin_amdgcn_readfirstlane(tid >> 6);
    const int map = wid >> 2, qs = wid & 3, q0w = qb * 128 + qs * 32;
    const size_t rowb = (size_t)b * SEQ;
    f32x16 o[4]; float lsum;
    flash_sweep<2, 128, true>(lds, P + (rowb + q0w + r32) * DIN + h * 128 + map * 64, P + rowb * DIN + 512 + h * 128, DIN, P + rowb * DIN + 1024 + h * 128, DIN,
                              2 * (qb + 1), q0w, o, lsum);
    const float inv = 1.f / lsum;
    LAS float* xch = (LAS float*)(lds + 65536) + qs * 4096;
    if (map == 1) {
#pragma unroll
        for (int d = 0; d < 4; ++d)
#pragma unroll
            for (int r = 0; r < 16; ++r) xch[(d * 16 + r) * 64 + lane] = o[d][r] * inv;
    }
    __syncthreads();
    if (map == 0) {
        float sq = 0.f;
#pragma unroll
        for (int d = 0; d < 4; ++d)
#pragma unroll
            for (int r = 0; r < 16; ++r) { const float v = o[d][r] * inv - lam * xch[(d * 16 + r) * 64 + lane]; o[d][r] = v; sq += v * v; }
        sq += swap32(sq);
        const float rs = __builtin_amdgcn_rsqf(sq * (1.f / 128.f) + EPS) * oscale;
        bf16_t* orow = MIX + (rowb + q0w + r32) * DM + h * 128;
#pragma unroll
        for (int d = 0; d < 4; ++d)
#pragma unroll
            for (int g4 = 0; g4 < 4; ++g4) {
                const int dd = 32 * d + 8 * g4 + 4 * hi;
                const f32x4 gn = *(const f32x4*)(subln + dd);
                u32x2 w; w.x = cvtpk(o[d][4 * g4] * rs * gn[0], o[d][4 * g4 + 1] * rs * gn[1]); w.y = cvtpk(o[d][4 * g4 + 2] * rs * gn[2], o[d][4 * g4 + 3] * rs * gn[3]);
                *(u32x2*)(orow + dd) = w;
            }
    }
    __syncthreads();
}

__device__ __forceinline__ void cross_unit(LAS unsigned char* lds, const bf16_t* QC, const bf16_t* KVC, bf16_t* OC, int b, int h, int qb, int layer) {
    int tid = threadIdx.x; asm volatile("" : "+v"(tid));
    const int lane = tid & 63, r32 = lane & 31, hi = lane >> 5, wid = __builtin_amdgcn_readfirstlane(tid >> 6);
    const size_t row = (size_t)b * SEQ + qb * 256 + wid * 32 + r32;
    const bf16_t* kbase = KVC + (size_t)b * MEML * 2048 + layer * 512 + h * 64;
    f32x16 o[2]; float lsum;
    flash_sweep<1, 64, false>(lds, QC + row * 256 + h * 64, kbase, 2048, kbase + 256, 2048, 4, 0, o, lsum);
    const float inv = 1.f / lsum;
    bf16_t* orow = OC + row * 256 + h * 64;
#pragma unroll
    for (int d = 0; d < 2; ++d)
#pragma unroll
        for (int g4 = 0; g4 < 4; ++g4) {
            u32x2 w; w.x = cvtpk(o[d][4 * g4] * inv, o[d][4 * g4 + 1] * inv); w.y = cvtpk(o[d][4 * g4 + 2] * inv, o[d][4 * g4 + 3] * inv);
            *(u32x2*)(orow + 32 * d + 8 * g4 + 4 * hi) = w;
        }
}

__device__ __forceinline__ void sb_wave_unit(LAS unsigned char* wl, const bf16_t* P, bf16_t* MIX, int b, int h, int blk, const float* gn_b) {
    int tid = threadIdx.x; asm volatile("" : "+v"(tid));
    const int lane = tid & 63, r32 = lane & 31, hi = lane >> 5;
    const size_t rowb = (size_t)b * SEQ;
    const bf16_t* Qrow = P + (rowb + 32 * blk + r32) * DIN + 1536 + h * 64;
    const bf16_t* Kb = P + rowb * DIN + 1792 + h * 64;
    const bf16_t* Vb = P + rowb * DIN + 2048 + h * 64;
    bf16x8 qf[4];
#pragma unroll
    for (int ks = 0; ks < 4; ++ks) qf[ks] = *(const bf16x8*)(Qrow + ks * 16 + hi * 8);
    f32x16 o[2];
    o[0] = (f32x16){0.f, 0.f, 0.f, 0.f, 0.f, 0.f, 0.f, 0.f, 0.f, 0.f, 0.f, 0.f, 0.f, 0.f, 0.f, 0.f}; o[1] = o[0];
    float C = 0.f;
    const int vlane = ((lane >> 4) & 1) * 32 + (lane & 3) * 8 + (4 * hi + ((lane & 15) >> 2)) * 64;
    for (int j = blk; j >= 0; --j) {
        const int key0 = 32 * j;
        bf16x8 kf[4]; u32x4 vv[4];
#pragma unroll
        for (int ks = 0; ks < 4; ++ks) kf[ks] = *(const bf16x8*)(Kb + (size_t)(key0 + r32) * DIN + ks * 16 + hi * 8);
#pragma unroll
        for (int p = 0; p < 4; ++p) vv[p] = *(const u32x4*)(Vb + (size_t)(key0 + 16 * (p & 1) + (lane >> 2)) * DIN + (p >> 1) * 32 + (lane & 3) * 8);
        f32x16 z = (f32x16){0.f, 0.f, 0.f, 0.f, 0.f, 0.f, 0.f, 0.f, 0.f, 0.f, 0.f, 0.f, 0.f, 0.f, 0.f, 0.f};
#pragma unroll
        for (int ks = 0; ks < 4; ++ks) z = mfma32(kf[ks], qf[ks], z);
#pragma unroll
        for (int p = 0; p < 4; ++p) *(LAS u32x4*)(wl + p * 1024 + lane * 16) = vv[p];
        const bool diag = (j == blk);
        float lk[16], lsg[16], gs[4], pg[4];
#pragma unroll
        for (int r = 0; r < 16; ++r) {
            const bool strict = !diag || (crow(r, hi) < r32);
            const float z2 = z[r] * LOG2E;
            const float sp = fmaxf(z2, 0.f) + lg2(1.f + ex2(-fabsf(z2)));
            lk[r] = strict ? -sp : 0.f;
            lsg[r] = strict ? (z2 - sp) : -INFINITY;
        }
#pragma unroll
        for (int g = 0; g < 4; ++g) { gs[g] = (lk[4 * g] + lk[4 * g + 1]) + (lk[4 * g + 2] + lk[4 * g + 3]); pg[g] = swap32(gs[g]); }
        float sfx[4];
        { float own = 0.f, par = 0.f;
#pragma unroll
          for (int g = 3; g >= 0; --g) { sfx[g] = C + own + par + ((hi == 0) ? pg[g] : 0.f); own += gs[g]; par += pg[g]; }
          C += own + par; }
        float w[16];
#pragma unroll
        for (int g = 0; g < 4; ++g) {
            float run = sfx[g];
#pragma unroll
            for (int e = 3; e >= 0; --e) { w[4 * g + e] = ex2(lsg[4 * g + e] + run); run += lk[4 * g + e]; }
        }
        bf16x8 pw[2];
        { u32x4 t;
          t.x = cvtpk(w[0], w[1]); t.y = cvtpk(w[2], w[3]); t.z = cvtpk(w[4], w[5]); t.w = cvtpk(w[6], w[7]); pw[0] = __builtin_bit_cast(bf16x8, t);
          t.x = cvtpk(w[8], w[9]); t.y = cvtpk(w[10], w[11]); t.z = cvtpk(w[12], w[13]); t.w = cvtpk(w[14], w[15]); pw[1] = __builtin_bit_cast(bf16x8, t); }
#pragma unroll
        for (int d = 0; d < 2; ++d)
#pragma unroll
            for (int ks = 0; ks < 2; ++ks) o[d] = mfma32(vfrag(wl + vlane + d * 2048 + ks * 1024), pw[ks], o[d]);
        if (__all(C < -160.f)) break;
    }
    float sq = 0.f;
#pragma unroll
    for (int d = 0; d < 2; ++d)
#pragma unroll
        for (int r = 0; r < 16; ++r) sq += o[d][r] * o[d][r];
    sq += swap32(sq);
    const float rs = __builtin_amdgcn_rsqf(sq * (1.f / 64.f) + EPS);
    bf16_t* orow = MIX + (rowb + 32 * blk + r32) * DM + 512 + h * 64;
#pragma unroll
    for (int d = 0; d < 2; ++d)
#pragma unroll
        for (int g4 = 0; g4 < 4; ++g4) {
            const int dd = 32 * d + 8 * g4 + 4 * hi;
            const f32x4 gn = *(const f32x4*)(gn_b + h * 64 + dd);
            u32x2 t; t.x = cvtpk(o[d][4 * g4] * rs * gn[0], o[d][4 * g4 + 1] * rs * gn[1]); t.y = cvtpk(o[d][4 * g4 + 2] * rs * gn[2], o[d][4 * g4 + 3] * rs * gn[3]);
            *(u32x2*)(orow + dd) = t;
        }
}

__device__ __forceinline__ void sgu_unit(LAS unsigned char* lds, const bf16_t* P, bf16_t* MIX, int b, int ch, int g, const float* sgn, const float* wsp, const float* bsp, const float* gno) {
    int tid = threadIdx.x; asm volatile("" : "+v"(tid));
    LAS float* Wl = (LAS float*)lds;
    LAS float* Vl = (LAS float*)(lds + 128 * 129 * 4);
    const size_t row0 = (size_t)b * SEQ + ch * 128;
    for (int i = tid; i < 128 * 128; i += NTHR) { const int t = i >> 7, s = i & 127; Wl[t * 129 + s] = (s <= t) ? wsp[(size_t)g * 16384 + i] : 0.f; }
    {
        const int t = tid >> 2, q = tid & 3;
        const bf16_t* vp = P + (row0 + t) * DIN + 2560 + g * 64 + q * 16;
        const u32x4 a = *(const u32x4*)vp, c = *(const u32x4*)(vp + 8);
        float v[16] = {bflo(a.x), bfhi(a.x), bflo(a.y), bfhi(a.y), bflo(a.z), bfhi(a.z), bflo(a.w), bfhi(a.w), bflo(c.x), bfhi(c.x), bflo(c.y), bfhi(c.y), bflo(c.z), bfhi(c.z), bflo(c.w), bfhi(c.w)};
        float sq = 0.f;
#pragma unroll
        for (int e = 0; e < 16; ++e) sq += v[e] * v[e];
        sq += __shfl_xor(sq, 1); sq += __shfl_xor(sq, 2);
        const float rs = __builtin_amdgcn_rsqf(sq * (1.f / 64.f) + EPS);
#pragma unroll
        for (int e = 0; e < 16; ++e) Vl[t * 64 + q * 16 + e] = v[e] * rs * sgn[g * 64 + q * 16 + e];
    }
    __syncthreads();
    const int ty = tid >> 4, tx = tid & 15;
    float acc[4][4];
#pragma unroll
    for (int i = 0; i < 4; ++i)
#pragma unroll
        for (int j = 0; j < 4; ++j) acc[i][j] = 0.f;
    for (int s = 0; s < 128; ++s) {
        const f32x4 vv = *(const LAS f32x4*)(Vl + s * 64 + tx * 4);
#pragma unroll
        for (int i = 0; i < 4; ++i) { const float w = Wl[(ty + 32 * i) * 129 + s];
#pragma unroll
            for (int j = 0; j < 4; ++j) acc[i][j] += w * vv[j]; }
    }
#pragma unroll
    for (int i = 0; i < 4; ++i) {
        const int t = ty + 32 * i;
        const float bias = bsp[g * 128 + t];
        const u32x2 uu = *(const u32x2*)(P + (row0 + t) * DIN + 2304 + g * 64 + tx * 4);
        float ov[4] = {bflo(uu.x) * (acc[i][0] + bias), bfhi(uu.x) * (acc[i][1] + bias), bflo(uu.y) * (acc[i][2] + bias), bfhi(uu.y) * (acc[i][3] + bias)};
        float sq = ov[0] * ov[0] + ov[1] * ov[1] + ov[2] * ov[2] + ov[3] * ov[3];
        sq += __shfl_xor(sq, 1); sq += __shfl_xor(sq, 2); sq += __shfl_xor(sq, 4); sq += __shfl_xor(sq, 8);
        const float rs = __builtin_amdgcn_rsqf(sq * (1.f / 64.f) + EPS);
        const f32x4 gn = *(const f32x4*)(gno + g * 64 + tx * 4);
        u32x2 w; w.x = cvtpk(ov[0] * rs * gn[0], ov[1] * rs * gn[1]); w.y = cvtpk(ov[2] * rs * gn[2], ov[3] * rs * gn[3]);
        *(u32x2*)(MIX + (row0 + t) * DM + 768 + g * 64 + tx * 4) = w;
    }
    __syncthreads();
}

__device__ __forceinline__ void transpose_item(const float* W, int N, const float* gain, bf16_t* WT, int ldt, int k0, int n0, LAS float* scr, int lane) {
    f32x4 v[16];
#pragma unroll
    for (int i = 0; i < 16; ++i) v[i] = *(const f32x4*)(W + (size_t)(k0 + 4 * i + (lane >> 4)) * N + n0 + (lane & 15) * 4);
#pragma unroll
    for (int i = 0; i < 16; ++i) {
        const int k = 4 * i + (lane >> 4);
        const float gk = gain ? gain[k0 + k] : 1.f;
#pragma unroll
        for (int e = 0; e < 4; ++e) scr[k * 65 + (lane & 15) * 4 + e] = v[i][e] * gk;
    }
    LDS_WAIT();
    const int kc = lane >> 3;
#pragma unroll
    for (int j = 0; j < 8; ++j) {
        const int n = 8 * j + (lane & 7);
        const LAS float* s = scr + (8 * kc) * 65 + n;
        u32x4 o; o.x = cvtpk(s[0], s[65]); o.y = cvtpk(s[2 * 65], s[3 * 65]); o.z = cvtpk(s[4 * 65], s[5 * 65]); o.w = cvtpk(s[6 * 65], s[7 * 65]);
        *(u32x4*)(WT + (size_t)(n0 + n) * ldt + k0 + 8 * kc) = o;
    }
    LDS_WAIT();
}

struct Args {
    const float* x; const float* mem; const int* pos; const float* norm_mix; const float* w_in; const float* lam_q1; const float* lam_k1; const float* lam_q2; const float* lam_k2;
    const float* subln_a; const float* norm_b_out; const float* sgu_norm; const float* w_spatial; const float* b_spatial; const float* norm_c_out; const float* w_out;
    const float* norm_cross; const float* norm_mem; const float* w_cq; const float* w_ck; const float* w_cv; const float* w_co; const float* norm_ffn;
    const float* w_group; const float* b_group; const float* w_router; const float* b_router; const float* w_gate; const float* w_up; const float* w_down; const float* norm_final;
    float* out; unsigned char* ws; int ph_lo, ph_hi;
};
constexpr int PH_PER_LAYER = 10, PH_LAYER0 = 2, PH_FINAL = PH_LAYER0 + DEPTH * PH_PER_LAYER, N_PHASES = PH_FINAL + 1;

typedef __attribute__((address_space(4))) const Args* KArgP;
__device__ __forceinline__ KArgP kargs() { KArgP p = (KArgP)__builtin_amdgcn_kernarg_segment_ptr(); asm volatile("" : "+s"(p)); return p; }
#define KA (kargs())
template <class T> __device__ __forceinline__ T* asg(T* p) { GAS T* q = (GAS T*)p; asm volatile("" : "+s"(q)); return (T*)q; }
__device__ __forceinline__ unsigned char* opq(unsigned char* p) { return asg(p); }
#define X ((float*)(opq(ws) + WS_X))
#define XB ((bf16_t*)(opq(ws) + WS_XB))
#define PROJ ((bf16_t*)(opq(ws) + WS_PROJ))
#define MIX ((bf16_t*)(opq(ws) + WS_MIX))
#define QC ((bf16_t*)(opq(ws) + WS_QC))
#define OC ((bf16_t*)(opq(ws) + WS_OC))
#define HS ((bf16_t*)(opq(ws) + WS_HS))
#define ACT ((bf16_t*)(opq(ws) + WS_ACT))
#define MEMBF ((bf16_t*)(opq(ws) + WS_MEMBF))
#define KVC ((bf16_t*)(opq(ws) + WS_KVC))
#define WIN ((bf16_t*)(opq(ws) + WS_WIN))
#define WOUT ((bf16_t*)(opq(ws) + WS_WOUT))
#define WCKV ((bf16_t*)(opq(ws) + WS_WCKV))
#define WCQ ((bf16_t*)(opq(ws) + WS_WCQ))
#define WCO ((bf16_t*)(opq(ws) + WS_WCO))
#define WGU ((bf16_t*)(opq(ws) + WS_WGU))
#define WD ((bf16_t*)(opq(ws) + WS_WD))
#define SS0 ((float*)(opq(ws) + WS_SS0))
#define SS1 ((float*)(opq(ws) + WS_SS1))
#define SSMEM ((float*)(opq(ws) + WS_SSMEM))
#define LAMV ((float*)(opq(ws) + WS_LAMV))
#define RSTD2 ((float*)(opq(ws) + WS_RSTD2))
#define CTOK ((int*)(opq(ws) + WS_CTOK))
#define CRS ((float*)(opq(ws) + WS_CRS))
#define CWT ((float*)(opq(ws) + WS_CWT))
#define ROT ((float*)(opq(ws) + WS_ROT))
#define SLOTTOK ((int*)(opq(ws) + WS_SLOTTOK))
#define SLOTW ((float*)(opq(ws) + WS_SLOTW))
__global__ void __launch_bounds__(NTHR, 2) fwd_kernel(Args a) {
    extern __shared__ __attribute__((aligned(16))) unsigned char lds_raw[];
    LAS unsigned char* lds = (LAS unsigned char*)lds_raw;
    volatile LAS unsigned* MISC = (volatile LAS unsigned*)(lds + MISC_OFF);
    const int tid = threadIdx.x, lane = tid & 63, wave = __builtin_amdgcn_readfirstlane(tid >> 6);
    const int G = gridDim.x, bx = blockIdx.x, vcu = (G % 8 == 0) ? (bx % 8) * (G / 8) + bx / 8 : bx;
    unsigned char* ws = a.ws;
    gu32* ctl = (gu32*)(ws + WS_CTL);
    for (int u = tid; u < (LDS_BYTES - MISC_OFF) / 4; u += NTHR) MISC[u] = 0u;
    __syncthreads();
    XcdBarrier bar; bar.bar = (unsigned*)ctl + CW_BAR; bar.x = 0; bar.st = nullptr;
    if (!MK_MULTI) bar = xcd_barrier_post((unsigned*)ctl + CW_BAR, MISC);
    const int lo = a.ph_lo, hi_ph = a.ph_hi;
#ifndef PHEN
#define PHEN 0xffff
#endif
#define EN(b) ((PHEN >> (b)) & 1)
#define IN(k) (lo <= (k) && (k) < hi_ph)
#define SEAM(k) do { if (!MK_MULTI && IN(k) && IN((k) + 1)) xcd_barrier(bar); } while (0)

    const int gw_ = vcu * NWAVES + wave, NGW = G * NWAVES;

    if (EN(0) && IN(0)) {
        int tid = threadIdx.x; asm volatile("" : "+v"(tid)); const int lane = tid & 63; int gw = gw_; asm volatile("" : "+s"(gw));
        LAS float* scr = (LAS float*)(lds + wave * 16640);
        constexpr int I_GU = 128 * 128, I_D = 64 * 128, I_IN = 4 * 16 * 44, I_OUT = 4 * 256, I_C3 = 12 * 64, I_CO = 4 * 64;
        constexpr int NITEMS = I_GU + I_D + I_IN + I_OUT + I_C3 + I_CO;
        for (int it = gw; it < NITEMS; it += NGW) {
            int r = it;
            if (r < I_GU) { const int mtx = r >> 7, t = r & 127, le = mtx >> 1, up = mtx & 1, kb = t >> 3, nb = t & 7;
                transpose_item((up ? asg(KA->w_up) : asg(KA->w_gate)) + (size_t)le * 1024 * 512, 512, asg(KA->norm_ffn) + (le >> 4) * 1024, WGU + ((size_t)le * 1024 + up * 512) * 1024, 1024, kb * 64, nb * 64, scr, lane); continue; }
            r -= I_GU;
            if (r < I_D) { const int le = r >> 7, t = r & 127, kb = t >> 4, nb = t & 15;
                transpose_item(asg(KA->w_down) + (size_t)le * 512 * 1024, 1024, nullptr, WD + (size_t)le * 1024 * 512, 512, kb * 64, nb * 64, scr, lane); continue; }
            r -= I_D;
            if (r < I_IN) { const int l = r / 704, t = r % 704, kb = t / 44, nb = t % 44;
                transpose_item(asg(KA->w_in) + (size_t)l * 1024 * DIN, DIN, asg(KA->norm_mix) + l * 1024, WIN + (size_t)l * DIN * 1024, 1024, kb * 64, nb * 64, scr, lane); continue; }
            r -= I_IN;
            if (r < I_OUT) { const int l = r >> 8, t = r & 255, kb = t >> 4, nb = t & 15;
                transpose_item(asg(KA->w_out) + (size_t)l * 1024 * 1024, 1024, nullptr, WOUT + (size_t)l * 1024 * 1024, 1024, kb * 64, nb * 64, scr, lane); continue; }
            r -= I_OUT;
            if (r < I_C3) { const int mtx = r >> 6, t = r & 63, l = mtx / 3, which = mtx % 3, kb = t >> 2, nb = t & 3;
                const float* src = (which == 0 ? asg(KA->w_ck) : which == 1 ? asg(KA->w_cv) : asg(KA->w_cq)) + (size_t)l * 1024 * 256;
                bf16_t* dst = (which == 2) ? WCQ + (size_t)l * 256 * 1024 : WCKV + ((size_t)l * 512 + which * 256) * 1024;
                transpose_item(src, 256, (which == 2 ? asg(KA->norm_cross) : asg(KA->norm_mem)) + l * 1024, dst, 1024, kb * 64, nb * 64, scr, lane); continue; }
            r -= I_C3;
            { const int l = r >> 6, t = r & 63, kb = t >> 4, nb = t & 15;
              transpose_item(asg(KA->w_co) + (size_t)l * 256 * 1024, 1024, nullptr, WCO + (size_t)l * 1024 * 256, 256, kb * 64, nb * 64, scr, lane); }
        }
        for (int m = gw; m < MTOK + MROWS; m += NGW) {
            const bool ismem = (m >= MTOK);
            const float* src = ismem ? asg(KA->mem) + (size_t)(m - MTOK) * DM : asg(KA->x) + (size_t)m * DM;
            bf16_t* dst = ismem ? MEMBF + (size_t)(m - MTOK) * DM : XB + (size_t)m * DM;
            float s = 0.f;
#pragma unroll
            for (int j = 0; j < 4; ++j) { const f32x4 v = *(const f32x4*)(src + j * 256 + lane * 4); s += v[0] * v[0] + v[1] * v[1] + v[2] * v[2] + v[3] * v[3];
                u32x2 w; w.x = cvtpk(v[0], v[1]); w.y = cvtpk(v[2], v[3]); *(u32x2*)(dst + j * 256 + lane * 4) = w; }
            s = wave_sum(s);
            if (ismem) { if (lane == 0) SSMEM[m - MTOK] = s; } else if (lane < 16) SS0[(size_t)m * 16 + lane] = (lane == 0) ? s : 0.f;
        }
        for (int i = bx * NTHR + tid; i < MTOK * 8; i += G * NTHR) {
            const int row = i >> 3, k = i & 7;
            const float invf = (float)exp2(-(double)k * (18.931568569324174 / 8.0));
            const float ang = (float)asg(KA->pos)[row] * invf;
            const double rev = (double)ang * 0.15915494309189535;
            const float fr = (float)(rev - floor(rev));
            ROT[(size_t)row * 16 + k] = __builtin_amdgcn_cosf(fr); ROT[(size_t)row * 16 + 8 + k] = __builtin_amdgcn_sinf(fr);
        }
        if (bx == 0 && wave == 0) {
            for (int l = 0; l < DEPTH; ++l) {
                const float s1 = wave_sum(asg(KA->lam_q1)[l * 64 + lane] * asg(KA->lam_k1)[l * 64 + lane]), s2 = wave_sum(asg(KA->lam_q2)[l * 64 + lane] * asg(KA->lam_k2)[l * 64 + lane]);
                const float lam_init = 0.8f - 0.6f * expf(-0.3f * (float)l);
                if (lane == 0) LAMV[l] = expf(s1) - expf(s2) + lam_init;
            }
        }
    }
    SEAM(0);
    if (EN(1) && IN(1)) {
        pg8::DenseOrder S; S.init(MEMBF, WCKV, DM, DM, MROWS, 2048, G, bx);
        pg8::GemmP g{DM, DM, DM, (size_t)128 * DM * 2, 1 << 20};
        EpiScale E{KVC, 2048, SSMEM, 1, 1.f};
        pg8::gemm_phase(lds, g, S, E);
    }
    SEAM(1);

#pragma unroll 1
    for (int l = 0; l < DEPTH; ++l) {
        const int p0 = PH_LAYER0 + l * PH_PER_LAYER;
        const float lam_init = 0.8f - 0.6f * expf(-0.3f * (float)l);
        if (EN(2) && IN(p0 + 0)) {
            pg8::DenseOrder S; S.init(XB, WIN + (size_t)l * DIN * DM, DM, DM, MTOK, DIN, G, bx);
            pg8::GemmP g{DM, DM, DM, (size_t)128 * DM * 2, 1 << 20};
            EpiInProj E{PROJ, SS0, ROT};
            pg8::gemm_phase(lds, g, S, E);
        }
        SEAM(p0 + 0);
        if (IN(p0 + 1)) {
            int gw = gw_; asm volatile("" : "+s"(gw));
            const float lam = LAMV[l];
            if (EN(12)) {
                const int j = vcu & 31, bh = 2 * (vcu >> 5) + (j >> 4), s = j & 15;
                if (G == 256) {
                    diff_unit(lds, PROJ, MIX, bh >> 2, bh & 3, 31 - s, lam, 1.f - lam_init, asg(KA->subln_a) + l * 128);
                    diff_unit(lds, PROJ, MIX, bh >> 2, bh & 3, s, lam, 1.f - lam_init, asg(KA->subln_a) + l * 128);
                } else {
                    for (int u = bx; u < 512; u += G) { const int bh2 = u >> 5; diff_unit(lds, PROJ, MIX, bh2 >> 2, bh2 & 3, u & 31, lam, 1.f - lam_init, asg(KA->subln_a) + l * 128); }
                }
            }
            if (EN(13)) for (int u = gw; u < 2048; u += NGW) { const int bh = u >> 7; sb_wave_unit(lds + wave * 4096, PROJ, MIX, bh >> 2, bh & 3, u & 127, asg(KA->norm_b_out) + l * 256); }
            __syncthreads();
            if (EN(14)) for (int u = bx; u < 512; u += G) { const int b = u >> 7, ch = (u >> 2) & 31, g = u & 3;
                sgu_unit(lds, PROJ, MIX, b, ch, g, asg(KA->sgu_norm) + l * 256, asg(KA->w_spatial) + (size_t)l * 4 * 16384, asg(KA->b_spatial) + l * 512, asg(KA->norm_c_out) + l * 256); }
        }
        SEAM(p0 + 1);
        if (EN(3) && IN(p0 + 2)) {
            pg8::DenseOrder S; S.init(MIX, WOUT + (size_t)l * DM * DM, DM, DM, MTOK, DM, G, bx);
            pg8::GemmP g{DM, DM, DM, (size_t)128 * DM * 2, 1 << 20};
            EpiResid E{l == 0 ? asg(KA->x) : X, X, XB, SS1, nullptr};
            pg8::gemm_phase(lds, g, S, E);
        }
        SEAM(p0 + 2);
        if (EN(4) && IN(p0 + 3)) {
            pg8::DenseOrder S; S.init(XB, WCQ + (size_t)l * 256 * DM, DM, DM, MTOK, 256, G, bx);
            pg8::GemmP g{DM, DM, DM, (size_t)128 * DM * 2, 1 << 20};
            EpiScale E{QC, 256, SS1, 16, 0.125f};
            pg8::gemm_phase(lds, g, S, E);
        }
        SEAM(p0 + 3);
        if (EN(5) && IN(p0 + 4)) {
            for (int u = bx; u < 256; u += G) cross_unit(lds, QC, KVC, OC, u >> 6, (u >> 4) & 3, u & 15, l);
        }
        SEAM(p0 + 4);
        if (EN(6) && IN(p0 + 5)) {
            pg8::DenseOrder S; S.init(OC, WCO + (size_t)l * DM * 256, 256, 256, MTOK, DM, G, bx);
            pg8::GemmP g{256, 256, 256, (size_t)128 * 256 * 2, 1 << 20};
            EpiResid E{X, X, XB, nullptr, nullptr};
            pg8::gemm_phase(lds, g, S, E);
        }
        SEAM(p0 + 5);
        if (EN(7) && IN(p0 + 6)) {
            int tid = threadIdx.x; asm volatile("" : "+v"(tid)); const int lane = tid & 63; int gw = gw_; asm volatile("" : "+s"(gw));
            LAS float* gW = (LAS float*)lds;
            for (int i = tid; i < 20 * 1024; i += NTHR) { const int j = i >> 10, k = i & 1023;
                const float w = (j < 4) ? asg(KA->w_group)[(size_t)l * 4096 + k * 4 + j] : asg(KA->w_router)[(size_t)l * 16384 + k * 16 + (j - 4)];
                gW[i] = w * asg(KA->norm_ffn)[l * 1024 + k]; }
            __syncthreads();
            LAS float* dl = (LAS float*)(lds + 20 * 1024 * 4) + wave * 32;
#pragma unroll 1
            for (int m = gw; m < MTOK; m += NGW) {
                float xv[16], s = 0.f, d[20];
#pragma unroll
                for (int i = 0; i < 16; ++i) { xv[i] = X[(size_t)m * DM + i * 64 + lane]; s += xv[i] * xv[i]; }
#pragma unroll 1
                for (int jg = 0; jg < 5; ++jg) {
                    float t0 = 0.f, t1 = 0.f, t2 = 0.f, t3 = 0.f;
                    const LAS float* gp = gW + jg * 4096 + lane;
#pragma unroll
                    for (int i = 0; i < 16; ++i) { t0 += xv[i] * gp[i * 64]; t1 += xv[i] * gp[1024 + i * 64]; t2 += xv[i] * gp[2048 + i * 64]; t3 += xv[i] * gp[3072 + i * 64]; }
                    t0 = wave_sum(t0); t1 = wave_sum(t1); t2 = wave_sum(t2); t3 = wave_sum(t3);
                    if (lane == 0) { dl[jg * 4] = t0; dl[jg * 4 + 1] = t1; dl[jg * 4 + 2] = t2; dl[jg * 4 + 3] = t3; }
                }
                s = wave_sum(s);
                LDS_WAIT();
#pragma unroll
                for (int j = 0; j < 20; ++j) d[j] = dl[j];
                const float rstd = 1.f / sqrtf(s * (1.f / DM) + EPS);
                float gl[4]; int gi = 0;
#pragma unroll
                for (int j = 0; j < 4; ++j) gl[j] = d[j] * rstd + asg(KA->b_group)[l * 4 + j];
                float gmax = gl[0];
#pragma unroll
                for (int j = 1; j < 4; ++j) if (gl[j] > gmax) { gmax = gl[j]; gi = j; }
                float den = 0.f;
#pragma unroll
                for (int j = 0; j < 4; ++j) den += expf(gl[j] - gmax);
                const float pgrp = 1.f / den;
                float el[4];
#pragma unroll
                for (int j = 0; j < 4; ++j) { float v = 0.f;
#pragma unroll
                    for (int q = 0; q < 4; ++q) v = (gi == q) ? d[4 + 4 * q + j] * rstd + asg(KA->b_router)[l * 16 + 4 * q + j] : v;
                    el[j] = v; }
                int i0 = 0, i1 = -1; float v0 = el[0], v1 = -INFINITY;
#pragma unroll
                for (int j = 1; j < 4; ++j) if (el[j] > v0) { v0 = el[j]; i0 = j; }
#pragma unroll
                for (int j = 0; j < 4; ++j) if (j != i0 && el[j] > v1) { v1 = el[j]; i1 = j; }
                const float e1 = expf(v1 - v0), w0 = pgrp / (1.f + e1), w1 = pgrp * e1 / (1.f + e1);
                const int elo = i0 < i1 ? i0 : i1, ehi = i0 < i1 ? i1 : i0;
                const float wlo = i0 < i1 ? w0 : w1, whi = i0 < i1 ? w1 : w0;
                const int pidx = (elo == 0) ? (ehi - 1) : (elo == 1 ? ehi + 1 : 5);
                const int bkt = gi * 6 + pidx;
                if (lane == 0) {
                    const unsigned pos = __hip_atomic_fetch_add((unsigned*)ctl + CW_CNT + 32 * l + bkt, 1u, __ATOMIC_RELAXED, __HIP_MEMORY_SCOPE_AGENT);
                    SLOTTOK[(size_t)bkt * SLOTCAP + pos] = m;
                    SLOTW[((size_t)bkt * SLOTCAP + pos) * 2] = wlo; SLOTW[((size_t)bkt * SLOTCAP + pos) * 2 + 1] = whi;
                    RSTD2[m] = rstd;
                }
            }
        }
        SEAM(p0 + 6);
        if (IN(p0 + 7) || IN(p0 + 8) || IN(p0 + 9)) {
            __syncthreads();
            if (tid == 0) { int acc = 0;
#pragma unroll 1
                for (int b = 0; b < NBUCKET; ++b) { MISC[16 + b] = (unsigned)acc;
                    const int nt_b = (int)((__hip_atomic_load((unsigned*)ctl + CW_CNT + 32 * l + b, __ATOMIC_RELAXED, __HIP_MEMORY_SCOPE_AGENT) + 255u) >> 8);
#pragma unroll 1
                    for (int q = 0; q < nt_b; ++q) MISC[48 + acc + q] = (unsigned)b;
                    acc += nt_b; }
                MISC[16 + NBUCKET] = (unsigned)acc; }
            __syncthreads();
        }
        const volatile LAS int* pre = (const volatile LAS int*)(MISC + 16);
        if (EN(8) && IN(p0 + 7)) {
            int tid = threadIdx.x; asm volatile("" : "+v"(tid)); const int lane = tid & 63; int gw = gw_; asm volatile("" : "+s"(gw));
            const int ncr = pre[NBUCKET] * 256;
            for (int cr = gw; cr < ncr; cr += NGW) {
                const int rt = cr >> 8;
                const int b = pre[32 + rt];
                const int idx = (rt - pre[b]) * 256 + (cr & 255);
                const int cnt = (int)__hip_atomic_load((unsigned*)ctl + CW_CNT + 32 * l + b, __ATOMIC_RELAXED, __HIP_MEMORY_SCOPE_AGENT);
                const bool valid = idx < cnt;
                const int tok = valid ? SLOTTOK[(size_t)b * SLOTCAP + idx] : -1;
                u32x4 v0 = (u32x4){0u, 0u, 0u, 0u}, v1 = v0;
                if (valid) { v0 = *(const u32x4*)(XB + (size_t)tok * DM + lane * 8); v1 = *(const u32x4*)(XB + (size_t)tok * DM + 512 + lane * 8); }
                *(u32x4*)(HS + (size_t)cr * DM + lane * 8) = v0; *(u32x4*)(HS + (size_t)cr * DM + 512 + lane * 8) = v1;
                if (lane == 0) { CTOK[cr] = tok; CRS[cr] = valid ? RSTD2[tok] : 0.f;
                    CWT[2 * cr] = valid ? SLOTW[((size_t)b * SLOTCAP + idx) * 2] : 0.f; CWT[2 * cr + 1] = valid ? SLOTW[((size_t)b * SLOTCAP + idx) * 2 + 1] : 0.f; }
            }
        }
        SEAM(p0 + 7);
        if (EN(9) && IN(p0 + 8)) {
            MoeOrder S{pre, (const char*)HS, (const char*)WGU, l, G, vcu, false};
            pg8::GemmP g{DM, DM, DM, (size_t)512 * DM * 2, 1 << 20};
            EpiG1 E{ACT, CRS, CWT};
            pg8::gemm_phase(lds, g, S, E);
        }
        SEAM(p0 + 8);
        if (EN(10) && IN(p0 + 9)) {
            MoeOrder S{pre, (const char*)ACT, (const char*)WD, l, G, vcu, true};
            pg8::GemmP g{DM, 512, DM, (size_t)128 * 512 * 2, 8};
            EpiResid E{X, X, XB, SS0, CTOK};
            pg8::gemm_phase(lds, g, S, E);
        }
        SEAM(p0 + 9);
    }
    if (EN(11) && IN(PH_FINAL)) {
        int tid = threadIdx.x; asm volatile("" : "+v"(tid)); const int lane = tid & 63; int gw = gw_; asm volatile("" : "+s"(gw));
        for (int m = gw; m < MTOK; m += NGW) {
            f32x4 v[4]; float sq = 0.f;
#pragma unroll
            for (int j = 0; j < 4; ++j) { v[j] = *(const f32x4*)(X + (size_t)m * DM + j * 256 + lane * 4); sq += v[j][0] * v[j][0] + v[j][1] * v[j][1] + v[j][2] * v[j][2] + v[j][3] * v[j][3]; }
            const float rs = 1.f / sqrtf(wave_sum(sq) * (1.f / DM) + EPS);
#pragma unroll
            for (int j = 0; j < 4; ++j) { const f32x4 gn = *(const f32x4*)(asg(KA->norm_final) + j * 256 + lane * 4);
                *(f32x4*)(asg(KA->out) + (size_t)m * DM + j * 256 + lane * 4) = v[j] * rs * gn; }
        }
    }
#undef IN
#undef SEAM
}
#undef X
#undef XB
#undef PROJ
#undef MIX
#undef QC
#undef OC
#undef HS
#undef ACT
#undef MEMBF
#undef KVC
#undef WIN
#undef WOUT
#undef WCKV
#undef WCQ
#undef WCO
#undef WGU
#undef WD
#undef SS0
#undef SS1
#undef SSMEM
#undef LAMV
#undef RSTD2
#undef CTOK
#undef CRS
#undef CWT
#undef ROT
#undef SLOTTOK
#undef SLOTW

extern "C" void kernel_launch(void* const* d_in, const int* in_sizes, int n_in, void* d_out, int out_size, void* d_ws, size_t ws_size, hipStream_t stream) {
    static int grid = 0;
    if (grid == 0) {
        if (n_in != 31 || in_sizes[0] != MTOK * DM || out_size != MTOK * DM || ws_size < WS_END) {
            fprintf(stderr, "kernel_launch: unexpected problem (n_in %d, in0 %d, out %d, ws %zu; need ws >= %zu); nothing launched\n", n_in, n_in > 0 ? in_sizes[0] : -1, out_size, ws_size, (size_t)WS_END); grid = -1; return; }
        int dev = 0, cus = 0, per_cu = 0;
        if (hipGetDevice(&dev) != hipSuccess || hipDeviceGetAttribute(&cus, hipDeviceAttributeMultiprocessorCount, dev) != hipSuccess) { grid = -1; return; }
        if (hipFuncSetAttribute((const void*)fwd_kernel, hipFuncAttributeMaxDynamicSharedMemorySize, LDS_BYTES) != hipSuccess) { fprintf(stderr, "kernel_launch: hipFuncSetAttribute failed\n"); grid = -1; return; }
        if (hipOccupancyMaxActiveBlocksPerMultiprocessor(&per_cu, (const void*)fwd_kernel, NTHR, LDS_BYTES) != hipSuccess || per_cu < 1) {
            fprintf(stderr, "kernel_launch: occupancy query reports %d workgroups per CU\n", per_cu); }
        (void)hipGetLastError();
        grid = cus;
    }
    if (grid < 0) return;
    if (hipMemsetAsync((char*)d_ws + WS_CTL, 0, CTL_ZERO_BYTES, stream) != hipSuccess) return;
    Args a{};
    const float** fp = (const float**)&a;
    for (int i = 0; i < 31; ++i) fp[i] = (const float*)d_in[i];
    a.out = (float*)d_out; a.ws = (unsigned char*)d_ws;
#if MK_MULTI
    for (int p = 0; p < N_PHASES; ++p) { a.ph_lo = p; a.ph_hi = p + 1; hipLaunchKernelGGL(fwd_kernel, dim3(grid), dim3(NTHR), LDS_BYTES, stream, a); }
#else
    a.ph_lo = 0; a.ph_hi = N_PHASES;
    hipLaunchKernelGGL(fwd_kernel, dim3(grid), dim3(NTHR), LDS_BYTES, stream, a);
#endif
}
```

```cpp
#include <hip/hip_runtime.h>
#include <cstdio>
#include <cstdint>
#include <type_traits>

#ifndef MK_MULTI
#define MK_MULTI 0
#endif

#define LAS __attribute__((address_space(3)))
#define GAS __attribute__((address_space(1)))
typedef unsigned short bf16_t;
typedef short bf16x8 __attribute__((ext_vector_type(8)));
typedef short s16x4 __attribute__((ext_vector_type(4)));
typedef float f32x2 __attribute__((ext_vector_type(2)));
typedef float f32x4 __attribute__((ext_vector_type(4)));
typedef float f32x16 __attribute__((ext_vector_type(16)));
typedef unsigned u32x2 __attribute__((ext_vector_type(2)));
typedef unsigned u32x4 __attribute__((ext_vector_type(4)));
typedef __bf16 bf16x2_t __attribute__((ext_vector_type(2)));
typedef GAS unsigned gu32;

constexpr int NB = 4, SEQ = 4096, DM = 1024, MTOK = NB * SEQ, DEPTH = 4, DIN = 2816;
constexpr int MEML = 256, MROWS = NB * MEML;
constexpr int NBUCKET = 24, SLOTCAP = MTOK, MAXCROWS = 22528;
constexpr float EPS = 1e-6f, LOG2E = 1.4426950408889634f;
constexpr int NWAVES = 8, NTHR = 512;

constexpr size_t MiB = 1u << 20;
constexpr size_t WS_CTL = 0, CTL_ZERO_BYTES = 128 * 1024;
constexpr int CW_BAR = 4096;
constexpr int CW_CNT = 16384;
constexpr size_t WS_SS0 = 462 * MiB;
constexpr size_t WS_SS1 = 463 * MiB;
constexpr size_t WS_SSMEM = 2 * MiB;
constexpr size_t WS_LAMV = 2 * MiB + 4096;
constexpr size_t WS_RSTD2 = 2 * MiB + 65536;
constexpr size_t WS_CTOK = 2 * MiB + 131072;
constexpr size_t WS_CRS = 2 * MiB + 262144;
constexpr size_t WS_CWT = 2 * MiB + 393216;
constexpr size_t WS_ROT = 3 * MiB;
constexpr size_t WS_SLOTTOK = 4 * MiB;
constexpr size_t WS_SLOTW = 6 * MiB;
constexpr size_t WS_MEMBF = 10 * MiB;
constexpr size_t WS_KVC = 12 * MiB;
constexpr size_t WS_X = 16 * MiB;
constexpr size_t WS_XB = 80 * MiB;
constexpr size_t WS_PROJ = 112 * MiB;
constexpr size_t WS_HS = 112 * MiB, WS_ACT = 156 * MiB;
constexpr size_t WS_MIX = 200 * MiB;
constexpr size_t WS_QC = 200 * MiB, WS_OC = 208 * MiB;
constexpr size_t WS_WIN = 232 * MiB, WS_WOUT = 254 * MiB, WS_WCKV = 262 * MiB, WS_WCQ = 266 * MiB, WS_WCO = 268 * MiB, WS_WGU = 270 * MiB, WS_WD = 398 * MiB;
constexpr size_t WS_GWT = 464 * MiB;
constexpr size_t WS_END = 465 * MiB;

constexpr int RING_BYTES = 131072, LDS_BYTES = 147456, MISC_OFF = LDS_BYTES - 1024;

__device__ __forceinline__ unsigned cvtpk(float lo, float hi) { f32x2 v = {lo, hi}; bf16x2_t b = __builtin_convertvector(v, bf16x2_t); return __builtin_bit_cast(unsigned, b); }
__device__ __forceinline__ float bf2f(unsigned short u) { return __builtin_bit_cast(float, (unsigned)u << 16); }
__device__ __forceinline__ float bflo(unsigned u) { return __builtin_bit_cast(float, u << 16); }
__device__ __forceinline__ float bfhi(unsigned u) { return __builtin_bit_cast(float, u & 0xffff0000u); }
__device__ __forceinline__ float ex2(float x) { return __builtin_amdgcn_exp2f(x); }
__device__ __forceinline__ float lg2(float x) { return __builtin_amdgcn_logf(x); }
__device__ __forceinline__ float wave_sum(float v) {
#pragma unroll
    for (int o = 1; o < 64; o <<= 1) v += __shfl_xor(v, o);
    return v;
}
__device__ __forceinline__ float swap32(float v) {
    auto rr = __builtin_amdgcn_permlane32_swap(__float_as_uint(v), __float_as_uint(v), false, false);
    return (threadIdx.x & 32) ? __uint_as_float(rr[0]) : __uint_as_float(rr[1]);
}
__device__ __forceinline__ int crow(int r, int hi) { return (r & 3) + 8 * (r >> 2) + 4 * hi; }
__device__ __forceinline__ float gelu_tanh(float x) {
    const float u = x * (0.7978845608028654f + 0.035677408136300125f * x * x);
    return x * __builtin_amdgcn_rcpf(1.f + ex2(-2.f * LOG2E * u));
}
__device__ __forceinline__ float sum16(const float* p) {
    const f32x4 a = *(const f32x4*)p, b = *(const f32x4*)(p + 4), c = *(const f32x4*)(p + 8), d = *(const f32x4*)(p + 12);
    return (((a[0] + a[1]) + (a[2] + a[3])) + ((b[0] + b[1]) + (b[2] + b[3]))) + (((c[0] + c[1]) + (c[2] + c[3])) + ((d[0] + d[1]) + (d[2] + d[3])));
}
#define VM_WAIT() asm volatile("s_waitcnt vmcnt(0)" ::: "memory")
#define LDS_WAIT() asm volatile("s_waitcnt lgkmcnt(0)" ::: "memory")

#define XB_TMO      128
#define XB_XCNT(j)  (256  + 64 * (j))
#define XB_XSUB(j)  (1280 + 64 * (j))
#define XB_XGEN(j)  (2304 + 64 * (j))
#define XB_TOP      3328
#define XB_TOPGEN   3392
#define XCD_BAR_WORDS 3456
#define XB_SPIN_CAP (1u << 18)
__device__ __forceinline__ unsigned xb_ld(unsigned* p)              { return __hip_atomic_load(p, __ATOMIC_RELAXED, __HIP_MEMORY_SCOPE_AGENT); }
__device__ __forceinline__ unsigned xb_add(unsigned* p, unsigned v) { return __hip_atomic_fetch_add(p, v, __ATOMIC_RELAXED, __HIP_MEMORY_SCOPE_AGENT); }
__device__ __forceinline__ unsigned xb_xcc_id() { return (unsigned)__builtin_amdgcn_s_getreg((3 << 11) | 20) & 0xFu; }
#define XB_SPIN(cond, bar) do { unsigned _sp = 0; while (cond) { __builtin_amdgcn_s_sleep(1); \
    if ((++_sp & 255u) == 0u) { if (xb_ld(&(bar)[XB_TMO])) break; if (_sp > XB_SPIN_CAP) { atomicAdd(&(bar)[XB_TMO], 1u); break; } } } } while (0)
struct XcdBarrier { unsigned* bar; unsigned x; volatile LAS unsigned* st; };
__device__ __forceinline__ XcdBarrier xcd_barrier_post(unsigned* bar, volatile LAS unsigned* st) {
    XcdBarrier b; b.bar = bar; b.x = xb_xcc_id(); b.st = st;
    if (threadIdx.x == 0) (void)xb_add(&bar[XB_XCNT(b.x)], 1u);
    return b;
}
__device__ __forceinline__ void xcd_barrier_complete(unsigned* bar, unsigned x, unsigned& nloc, unsigned& nx) {
    const unsigned G = gridDim.x * gridDim.y * gridDim.z;
    unsigned sum, cnt, mine, sp = 0u;
    for (;;) {
        sum = 0u; cnt = 0u; mine = 0u;
#pragma unroll
        for (unsigned j = 0; j < 16; ++j) { const unsigned c = xb_ld(&bar[XB_XCNT(j)]); sum += c; cnt += (c > 0u) ? 1u : 0u; mine = (j == x) ? c : mine; }
        if (sum == G) break;
        __builtin_amdgcn_s_sleep(1);
        if ((++sp & 255u) == 0u) { if (xb_ld(&bar[XB_TMO])) break; if (sp > XB_SPIN_CAP) { atomicAdd(&bar[XB_TMO], 1u); break; } }
    }
    nloc = mine > 0u ? mine : 1u; nx = cnt > 0u ? cnt : 1u;
}
__device__ __forceinline__ void xcd_barrier(const XcdBarrier& b) {
    asm volatile("s_waitcnt vmcnt(0)" ::: "memory");
    __syncthreads();
    if (threadIdx.x == 0) {
        unsigned* bar = b.bar;
        __builtin_amdgcn_s_waitcnt(0);
        unsigned nloc = b.st[0], nx = b.st[1];
        if (nloc == 0u) { xcd_barrier_complete(bar, b.x, nloc, nx); b.st[0] = nloc; b.st[1] = nx; }
        const unsigned old = xb_add(&bar[XB_XSUB(b.x)], 1u);
        const unsigned gen = old / nloc;
        if (old + 1u == (gen + 1u) * nloc) {
            __builtin_amdgcn_fence(__ATOMIC_RELEASE, "agent");
            asm volatile("s_waitcnt vmcnt(0)" ::: "memory");
            const unsigned og = xb_add(&bar[XB_TOP], 1u);
            const unsigned tg = og / nx;
            if (og + 1u == (tg + 1u) * nx) xb_add(&bar[XB_TOPGEN], 1u);
            else XB_SPIN(xb_ld(&bar[XB_TOPGEN]) == tg, bar);
            __builtin_amdgcn_fence(__ATOMIC_ACQUIRE, "agent");
            xb_add(&bar[XB_XGEN(b.x)], 1u);
            asm volatile("s_waitcnt vmcnt(0)" ::: "memory");
        } else {
            XB_SPIN(xb_ld(&bar[XB_XGEN(b.x)]) == gen, bar);
            __builtin_amdgcn_fence(__ATOMIC_ACQUIRE, "agent");
            asm volatile("s_waitcnt vmcnt(0)" ::: "memory");
        }
    }
    __syncthreads();
}

namespace pg8 {
constexpr int BM = 256, BK = 64, HALF = 128, HTB = HALF * BK * 2, NXCD = 8, WGM = 8;
__host__ __device__ __forceinline__ int lds_byte(int r, int c) { const int st = (r >> 4) * 2 + (c >> 5), rr = r & 15, cc = c & 31, ob = rr * 64 + cc * 2; return st * 1024 + (ob ^ (((ob >> 9) & 1) << 5)); }
__host__ __device__ __forceinline__ void stage_rc(int b, int& R, int& C) { const int st = b / 1024, sb = b % 1024, swz = sb ^ (((sb >> 9) & 1) << 5); R = (st >> 1) * 16 + swz / 64; C = (st & 1) * 32 + (swz % 64) / 2; }
__host__ __device__ __forceinline__ int perm32(int rho) { const int n = rho >> 4, i = rho & 15; return 8 * (i >> 2) + 4 * n + (i & 3); }

struct Unit { const char* A; const char* B; const char* B2; int pm, pn, aux; };
struct GemmP { int lda, ldb, K; size_t hstepB; int ksw; };

struct DenseOrder {
    const char* A; const char* Bt; int lda, ldb, nM, nN, nwg, G, c;
    __device__ void init(const void* A_, const void* Bt_, int lda_, int ldb_, int M, int N, int G_, int c_) { A = (const char*)A_; Bt = (const char*)Bt_; lda = lda_; ldb = ldb_; nM = M / BM; nN = N / BM; nwg = nM * nN; G = G_; c = c_; }
    __device__ bool next(int i, Unit& u) const {
        const long L = (long)i * G + c; if (L >= nwg) return false;
        int wgid = (int)L; { const int q = nwg / NXCD, r = nwg % NXCD, xcd = wgid % NXCD, off = wgid / NXCD; wgid = (xcd < r ? xcd * (q + 1) : r * (q + 1) + (xcd - r) * q) + off; }
        const int nig = WGM * nN, gid = wgid / nig, fm = gid * WGM, gsz = (nM - fm) < WGM ? (nM - fm) : WGM;
        u.pm = fm + ((wgid % nig) % gsz); u.pn = (wgid % nig) / gsz; u.aux = 0;
        u.A = A + (size_t)u.pm * BM * lda * 2; u.B = Bt + (size_t)u.pn * BM * ldb * 2; u.B2 = u.B; return true;
    }
};

template <class Epi, class Sched>
__device__ __forceinline__ void gemm_phase(LAS unsigned char* lds, const GemmP g, const Sched& S, const Epi& E) {
    int tid = threadIdx.x; asm volatile("" : "+v"(tid));
    const int wid = __builtin_amdgcn_readfirstlane(tid >> 6), lane = tid & 63, wr = wid >> 2, wc = wid & 3, fr = lane & 15, fq = lane >> 4;
    const int K = g.K, nt = K / BK, ksw = g.ksw;
    unsigned voffA[2], voffB[2];
#pragma unroll
    for (int i = 0; i < 2; ++i) { int R, C; stage_rc(tid * 16 + i * 8192, R, C); const int Rb = (R & ~31) + perm32(R & 31);
        voffA[i] = (unsigned)(R * g.lda + C) * 2u; voffB[i] = (unsigned)(Rb * g.ldb + C) * 2u; }
    const size_t kstep = (size_t)(BK * 2);
    const size_t hstepA = (size_t)HALF * g.lda * 2, hstepB = g.hstepB;
    const unsigned ldsw = (unsigned)wid * 1024u;
    const int aoff = lds_byte(wr * 64 + fr, fq * 8), boff = lds_byte(wc * 32 + fr, fq * 8);
#define PG8_SA(b, h) (((b) * 2 + (h)) * HTB)
#define PG8_SB(b, h) ((4 + (b) * 2 + (h)) * HTB)
#define PG8_STAGE(bufoff, gbase, voff) do { _Pragma("unroll") for (int _i = 0; _i < 2; ++_i) \
        __builtin_amdgcn_global_load_lds((const unsigned*)((const char*)(gbase) + (voff)[_i]), (LAS unsigned*)(lds + (bufoff) + ldsw + _i * 8192), 16, 0, 0); } while (0)
#define PG8_LDA(dst, b, h) do { _Pragma("unroll") for (int m = 0; m < 4; ++m) _Pragma("unroll") for (int k = 0; k < 2; ++k) dst[m][k] = *(const LAS bf16x8*)(lds + PG8_SA(b, h) + aoff + m * 2048 + k * 1024); } while (0)
#define PG8_LDB(dst, b, h) do { _Pragma("unroll") for (int n = 0; n < 2; ++n) _Pragma("unroll") for (int k = 0; k < 2; ++k) dst[n][k] = *(const LAS bf16x8*)(lds + PG8_SB(b, h) + boff + n * 2048 + k * 1024); } while (0)
#define PG8_MMA(ai, bj, At, Bt) do { __builtin_amdgcn_s_setprio(1); _Pragma("unroll") for (int m = 0; m < 4; ++m) _Pragma("unroll") for (int n = 0; n < 2; ++n) _Pragma("unroll") for (int k = 0; k < 2; ++k) \
        acc[ai][bj][m][n] = __builtin_amdgcn_mfma_f32_16x16x32_bf16(Bt[n][k], At[m][k], acc[ai][bj][m][n], 0, 0, 0); __builtin_amdgcn_s_setprio(0); } while (0)
#define PG8_WAIT_V(n) asm volatile("s_waitcnt vmcnt(" #n ")" ::: "memory")
#define PG8_WAIT_L(n) asm volatile("s_waitcnt lgkmcnt(" #n ")" ::: "memory")
#define PG8_BAR __builtin_amdgcn_s_barrier()
#define PG8_SCHED __builtin_amdgcn_sched_barrier(0)
    Unit cur, nxt; int ui = 0;
    if (!S.next(0, cur)) return;
    f32x4 acc[2][2][4][2];
#pragma unroll
    for (int a = 0; a < 2; ++a)
#pragma unroll
        for (int b = 0; b < 2; ++b)
#pragma unroll
            for (int m = 0; m < 4; ++m)
#pragma unroll
                for (int n = 0; n < 2; ++n) acc[a][b][m][n] = (f32x4){0.f, 0.f, 0.f, 0.f};
    bf16x8 At[4][2], B0[2][2], B1[2][2];
    const char* cA = cur.A; const char* cB = cur.B; const char* cB2 = cur.B2;
    PG8_STAGE(PG8_SB(0, 0), cB, voffB); PG8_STAGE(PG8_SB(0, 1), cB + hstepB, voffB); PG8_STAGE(PG8_SA(0, 0), cA, voffA); PG8_STAGE(PG8_SA(0, 1), cA + hstepA, voffA);
    if (wr == 1) PG8_BAR;
    PG8_WAIT_V(2); PG8_BAR;
    PG8_STAGE(PG8_SB(1, 0), cB + kstep, voffB); PG8_STAGE(PG8_SA(1, 0), cA + kstep, voffA); PG8_STAGE(PG8_SB(1, 1), cB + hstepB + kstep, voffB);
    PG8_WAIT_V(6); PG8_BAR;
    for (;;) {
        const bool has_next = S.next(ui + 1, nxt);
        const char* nA = has_next ? nxt.A : cA; const char* nB = has_next ? nxt.B : cB;
#pragma unroll 1
        for (int t = 0; t < nt; t += 2) {
            const bool last = (t == nt - 2);
            const char* a1 = cA + (size_t)(t + 1) * kstep;
            const char* a2 = last ? nA : cA + (size_t)(t + 2) * kstep;
            const char* b2 = last ? nB : ((t + 2 < ksw) ? cB : cB2) + (size_t)(t + 2) * kstep;
            const char* a3 = a2 + kstep; const char* b3 = b2 + kstep;
            PG8_LDB(B0, 0, 0); PG8_LDB(B1, 0, 1); PG8_SCHED; PG8_LDA(At, 0, 0); PG8_STAGE(PG8_SA(1, 1), a1 + hstepA, voffA);
            PG8_WAIT_V(8); PG8_WAIT_L(0); PG8_BAR; PG8_MMA(0, 0, At, B0); PG8_MMA(0, 1, At, B1); PG8_BAR; PG8_SCHED;
            PG8_LDA(At, 0, 1); PG8_STAGE(PG8_SB(0, 0), b2, voffB); PG8_STAGE(PG8_SB(0, 1), b2 + hstepB, voffB); PG8_STAGE(PG8_SA(0, 0), a2, voffA);
            PG8_WAIT_V(8); PG8_WAIT_L(0); PG8_BAR; PG8_MMA(1, 0, At, B0); PG8_MMA(1, 1, At, B1); PG8_BAR; PG8_SCHED;
            PG8_LDB(B0, 1, 0); PG8_LDB(B1, 1, 1); PG8_SCHED; PG8_LDA(At, 1, 0); PG8_STAGE(PG8_SA(0, 1), a2 + hstepA, voffA);
            PG8_WAIT_V(8); PG8_WAIT_L(0); PG8_BAR; PG8_MMA(0, 0, At, B0); PG8_MMA(0, 1, At, B1); PG8_BAR; PG8_SCHED;
            PG8_LDA(At, 1, 1); PG8_STAGE(PG8_SB(1, 0), b3, voffB); PG8_STAGE(PG8_SB(1, 1), b3 + hstepB, voffB); PG8_STAGE(PG8_SA(1, 0), a3, voffA);
            PG8_WAIT_V(8); PG8_WAIT_L(0); PG8_BAR; PG8_MMA(1, 0, At, B0); PG8_MMA(1, 1, At, B1); PG8_BAR; PG8_SCHED;
        }
        if (wr == 0) PG8_BAR;
        E(acc, cur, wr, wc, fr, fq);
        if (!has_next) break;
#pragma unroll
        for (int a = 0; a < 2; ++a)
#pragma unroll
            for (int b = 0; b < 2; ++b)
#pragma unroll
                for (int m = 0; m < 4; ++m)
#pragma unroll
                    for (int n = 0; n < 2; ++n) acc[a][b][m][n] = (f32x4){0.f, 0.f, 0.f, 0.f};
        cur = nxt; cA = nA; cB = nB; cB2 = nxt.B2; ++ui;
        if (wr == 1) PG8_BAR;
    }
    PG8_WAIT_V(0);
    PG8_BAR;
#undef PG8_SA
#undef PG8_SB
#undef PG8_STAGE
#undef PG8_LDA
#undef PG8_LDB
#undef PG8_MMA
#undef PG8_WAIT_V
#undef PG8_WAIT_L
#undef PG8_BAR
#undef PG8_SCHED
}
}
typedef f32x4 Acc[2][2][4][2];

struct EpiInProj {
    bf16_t* P; const float* ss; const float* rot;
    __device__ __forceinline__ void operator()(const Acc& acc, const pg8::Unit& u, int wr, int wc, int fr, int fq) const {
        const int pn = u.pn;
        const float qs = (pn < 2 || pn == 6) ? 0.125f * LOG2E : 1.f;
        const bool rotary = (pn < 4) && ((wc & 1) == 0);
        const bool gelu = (pn >= 9);
#pragma unroll
        for (int ai = 0; ai < 2; ++ai)
#pragma unroll
            for (int m = 0; m < 4; ++m) {
                const int row = u.pm * 256 + ai * 128 + wr * 64 + m * 16 + fr;
                const float rs = __builtin_amdgcn_rsqf(sum16(ss + (size_t)row * 16) * (1.f / DM) + EPS) * qs;
                f32x4 cs[4];
                if (rotary) {
#pragma unroll
                    for (int j = 0; j < 4; ++j) cs[j] = *(const f32x4*)(rot + (size_t)row * 16 + 4 * j);
                }
#pragma unroll
                for (int bj = 0; bj < 2; ++bj) {
                    float v[8];
#pragma unroll
                    for (int e = 0; e < 4; ++e) { v[e] = acc[ai][bj][m][0][e] * rs; v[4 + e] = acc[ai][bj][m][1][e] * rs; }
                    if (rotary) {
#pragma unroll
                        for (int e = 0; e < 8; ++e) {
                            const float p = __shfl_xor(v[e], 16);
                            const float c = cs[e >> 2][e & 3], s = cs[2 + (e >> 2)][e & 3];
                            const float r0 = v[e] * c - p * s, r1 = v[e] * c + p * s;
                            v[e] = (fq == 0) ? r0 : ((fq == 1) ? r1 : v[e]);
                        }
                    }
                    if (gelu) {
#pragma unroll
                        for (int e = 0; e < 8; ++e) v[e] = gelu_tanh(v[e]);
                    }
                    u32x4 w; w.x = cvtpk(v[0], v[1]); w.y = cvtpk(v[2], v[3]); w.z = cvtpk(v[4], v[5]); w.w = cvtpk(v[6], v[7]);
                    *(u32x4*)(P + (size_t)row * DIN + pn * 256 + bj * 128 + wc * 32 + fq * 8) = w;
                }
            }
    }
};
struct EpiScale {
    bf16_t* O; int ldc; const float* ss; int nss; float scale;
    __device__ __forceinline__ void operator()(const Acc& acc, const pg8::Unit& u, int wr, int wc, int fr, int fq) const {
#pragma unroll
        for (int ai = 0; ai < 2; ++ai)
#pragma unroll
            for (int m = 0; m < 4; ++m) {
                const int row = u.pm * 256 + ai * 128 + wr * 64 + m * 16 + fr;
                const float rs = __builtin_amdgcn_rsqf((nss == 16 ? sum16(ss + (size_t)row * 16) : ss[row]) * (1.f / DM) + EPS) * scale;
#pragma unroll
                for (int bj = 0; bj < 2; ++bj) {
                    const f32x4 a = acc[ai][bj][m][0] * rs, b = acc[ai][bj][m][1] * rs;
                    u32x4 w; w.x = cvtpk(a[0], a[1]); w.y = cvtpk(a[2], a[3]); w.z = cvtpk(b[0], b[1]); w.w = cvtpk(b[2], b[3]);
                    *(u32x4*)(O + (size_t)row * ldc + u.pn * 256 + bj * 128 + wc * 32 + fq * 8) = w;
                }
            }
    }
};
struct EpiResid {
    const float* Xi; float* Xo; bf16_t* XB; float* ssout; const int* rowmap; int dummy;
    __device__ __forceinline__ void operator()(const Acc& acc, const pg8::Unit& u, int wr, int wc, int fr, int fq) const {
#pragma unroll
        for (int ai = 0; ai < 2; ++ai)
#pragma unroll
            for (int m = 0; m < 4; ++m) {
                const int r = ai * 128 + wr * 64 + m * 16 + fr;
                int row = u.pm * 256 + r;
                if (rowmap) row = rowmap[u.aux + r];
                float sq = 0.f;
                if (row >= 0) {
#pragma unroll
                    for (int bj = 0; bj < 2; ++bj) {
                        const size_t o = (size_t)row * DM + u.pn * 256 + bj * 128 + wc * 32 + fq * 8;
                        f32x4 a = *(const f32x4*)(Xi + o), b = *(const f32x4*)(Xi + o + 4);
                        a += acc[ai][bj][m][0]; b += acc[ai][bj][m][1];
                        const size_t o1 = dummy ? (size_t)(row & 8191) * DM + (o & 1023) : o, o2 = dummy ? (size_t)(row & 4095) * DM + (o & 1023) : o;
                        *(f32x4*)(Xo + o1) = a; *(f32x4*)(Xo + o1 + 4) = b;
                        sq += a[0] * a[0] + a[1] * a[1] + a[2] * a[2] + a[3] * a[3] + b[0] * b[0] + b[1] * b[1] + b[2] * b[2] + b[3] * b[3];
                        u32x4 w; w.x = cvtpk(a[0], a[1]); w.y = cvtpk(a[2], a[3]); w.z = cvtpk(b[0], b[1]); w.w = cvtpk(b[2], b[3]);
                        *(u32x4*)(XB + o2) = w;
                    }
                }
                sq += __shfl_xor(sq, 16); sq += __shfl_xor(sq, 32);
                if (fq == 0 && row >= 0 && ssout) ssout[(size_t)row * 16 + u.pn * 4 + wc] = sq;
            }
    }
};
struct EpiG1 {
    bf16_t* ACT; const float* crs; const float* cwt;
    __device__ __forceinline__ void operator()(const Acc& acc, const pg8::Unit& u, int wr, int wc, int fr, int fq) const {
        const int sel = u.pn >> 2, ch = u.pn & 3;
#pragma unroll
        for (int ai = 0; ai < 2; ++ai)
#pragma unroll
            for (int m = 0; m < 4; ++m) {
                const int cr = u.aux + ai * 128 + wr * 64 + m * 16 + fr;
                const float rs = crs[cr], wt = cwt[2 * cr + sel];
                float v[8];
#pragma unroll
                for (int n = 0; n < 2; ++n)
#pragma unroll
                    for (int e = 0; e < 4; ++e) {
                        const float gg = acc[ai][0][m][n][e] * rs, uu = acc[ai][1][m][n][e] * rs;
                        v[4 * n + e] = gg * __builtin_amdgcn_rcpf(1.f + ex2(-LOG2E * gg)) * uu * wt;
                    }
                u32x4 w; w.x = cvtpk(v[0], v[1]); w.y = cvtpk(v[2], v[3]); w.z = cvtpk(v[4], v[5]); w.w = cvtpk(v[6], v[7]);
                *(u32x4*)(ACT + (size_t)cr * DM + sel * 512 + ch * 128 + wc * 32 + fq * 8) = w;
            }
    }
};

__device__ __forceinline__ void bucket_experts(int b, int& elo, int& ehi) {
    const int grp = b / 6, p = b % 6;
    const int lo = p < 3 ? 0 : (p < 5 ? 1 : 2), hi = p < 3 ? p + 1 : (p < 5 ? p - 1 : 3);
    elo = grp * 4 + lo; ehi = grp * 4 + hi;
}
struct MoeOrder {
    const volatile LAS int* pre; const char* A; const char* W; int layer, G, vcu; bool g2;
    __device__ bool next(int i, pg8::Unit& u) const {
        const int ncol = g2 ? 4 : 8;
        const long L = (long)i * G + vcu; if (L >= (long)pre[NBUCKET] * ncol) return false;
        const int rt = (int)(L / ncol), pn = (int)(L % ncol);
        const int b = pre[32 + rt];
        int elo, ehi; bucket_experts(b, elo, ehi);
        u.pm = rt; u.pn = pn; u.aux = rt * 256;
        u.A = A + (size_t)rt * 256 * DM * 2;
        if (!g2) { const int e = (pn < 4) ? elo : ehi; u.B = W + ((size_t)(layer * 16 + e) * 1024 + (pn & 3) * 128) * DM * 2; u.B2 = u.B; }
        else { u.B = W + ((size_t)(layer * 16 + elo) * 1024 + pn * 256) * 512 * 2; u.B2 = W + ((size_t)(layer * 16 + ehi) * 1024 + pn * 256) * 512 * 2 - 8 * 128; }
        return true;
    }
};

__device__ __forceinline__ f32x16 mfma32(bf16x8 a, bf16x8 b, f32x16 c) { return __builtin_amdgcn_mfma_f32_32x32x16_bf16(a, b, c, 0, 0, 0); }
typedef short v4i16_t __attribute__((ext_vector_type(4)));
__device__ __forceinline__ s16x4 vtr(const LAS unsigned char* p) { return __builtin_bit_cast(s16x4, __builtin_amdgcn_ds_read_tr16_b64_v4i16((LAS v4i16_t*)p)); }
__device__ __forceinline__ bf16x8 vfrag(const LAS unsigned char* p) { const s16x4 lo = vtr(p), hi = vtr(p + 512); return (bf16x8){lo[0], lo[1], lo[2], lo[3], hi[0], hi[1], hi[2], hi[3]}; }

__device__ __forceinline__ void glds16(const void* gsrc, unsigned lds_dst) { unsigned keep;
    asm volatile("s_mov_b32 %0, m0\n\ts_mov_b32 m0, %2\n\ts_nop 0\n\tglobal_load_lds_dwordx4 %1, off\n\ts_mov_b32 m0, %0" : "=&s"(keep) : "v"(gsrc), "s"(lds_dst) : "memory"); }
__device__ __forceinline__ float max3f(float a, float b, float c) { return __builtin_fmaxf(__builtin_fmaxf(a, b), c); }
constexpr float RESC_THR = 8.f;

template <int NMAP, int VD, bool CAUSAL>
__device__ __forceinline__ void flash_sweep(LAS unsigned char* lds, const bf16_t* Qrow, const bf16_t* Kbase, int kpitch, const bf16_t* Vbase, int vpitch, int NT, int q0w,
                                            f32x16 (&o)[VD / 32], float& lsum) {
    constexpr int NDB = VD / 32, KBY = NMAP * 8192, VBY = NDB * 4096, VOFF = 3 * KBY, PPW = (NMAP * 8 + NDB * 4) / 8;
    int tid = threadIdx.x; asm volatile("" : "+v"(tid));
    const int lane = tid & 63, r32 = lane & 31, hi = lane >> 5, wid = __builtin_amdgcn_readfirstlane(tid >> 6);
    const int map = (NMAP == 2) ? (wid >> 2) : 0;
    const unsigned lds0 = (unsigned)(uintptr_t)lds;
    bf16x8 qf[4];
#pragma unroll
    for (int ks = 0; ks < 4; ++ks) qf[ks] = *(const bf16x8*)(Qrow + ks * 16 + hi * 8);
#pragma unroll
    for (int d = 0; d < NDB; ++d) o[d] = (f32x16){0.f, 0.f, 0.f, 0.f, 0.f, 0.f, 0.f, 0.f, 0.f, 0.f, 0.f, 0.f, 0.f, 0.f, 0.f, 0.f};
    float mref = 0.f; lsum = 0.f;
    const bf16_t* psrc[PPW]; unsigned pdst[PPW]; size_t pstep[PPW];
#pragma unroll
    for (int i = 0; i < PPW; ++i) {
        const int p = wid * PPW + i;
        if (p < NMAP * 8) { psrc[i] = Kbase + (size_t)lane * kpitch + (p >> 3) * 64 + (p & 7) * 8; pdst[i] = p * 1024; pstep[i] = (size_t)64 * kpitch; }
        else { const int pv = p - NMAP * 8; psrc[i] = Vbase + (size_t)(16 * (pv & 3) + (lane >> 2)) * vpitch + (pv >> 2) * 32 + (lane & 3) * 8; pdst[i] = VOFF + pv * 1024; pstep[i] = (size_t)64 * vpitch; }
    }
    auto issue = [&](int slot) {
#pragma unroll
        for (int i = 0; i < PPW; ++i) {
            const unsigned dst = lds0 + pdst[i] + slot * ((wid * PPW + i < NMAP * 8) ? KBY : VBY);
            glds16(psrc[i], (unsigned)__builtin_amdgcn_readfirstlane(dst));
            psrc[i] += pstep[i];
        }
    };
    auto qk = [&](int slot, float negm, f32x16& p0, f32x16& p1) {
        const LAS unsigned char* kb = lds + slot * KBY + map * 8192 + hi * 1024 + r32 * 16;
        f32x16 c;
#pragma unroll
        for (int r = 0; r < 16; ++r) c[r] = negm;
        p0 = c; p1 = c;
#pragma unroll
        for (int ks = 0; ks < 4; ++ks) {
            const bf16x8 k0 = *(const LAS bf16x8*)(kb + ks * 2048), k1 = *(const LAS bf16x8*)(kb + ks * 2048 + 512);
            p0 = mfma32(k0, qf[ks], p0); p1 = mfma32(k1, qf[ks], p1);
        }
    };
    const int vlane = ((lane >> 4) & 1) * 32 + (lane & 3) * 8 + (4 * hi + ((lane & 15) >> 2)) * 64;
    issue(0); issue(1);
    asm volatile("s_waitcnt vmcnt(%0)" :: "n"(PPW) : "memory");
    __builtin_amdgcn_s_barrier();
    f32x16 s0, s1;
    qk(0, 0.f, s0, s1);
    int slot = 0;
    auto step = [&](int t, auto maskedc, auto firstc) {
        constexpr bool MASKED = decltype(maskedc)::value, FIRST = decltype(firstc)::value;
        const int slot1 = (slot == 2) ? 0 : slot + 1, slot2 = (slot1 == 2) ? 0 : slot1 + 1;
        VM_WAIT(); LDS_WAIT(); __builtin_amdgcn_s_barrier();
        if (t + 2 < NT) issue(slot2);
        if (MASKED) {
            const int qq = q0w + r32 - 64 * t;
#pragma unroll
            for (int r = 0; r < 16; ++r) { const int kv = crow(r, hi); if (kv > qq) s0[r] = -INFINITY; if (kv + 32 > qq) s1[r] = -INFINITY; }
        }
        float ra = max3f(s0[0], s0[1], s1[0]), rb = max3f(s0[2], s0[3], s1[1]); ra = max3f(ra, s1[2], s1[3]);
#pragma unroll
        for (int r = 4; r < 16; r += 4) { ra = max3f(ra, s0[r], s0[r + 1]); rb = max3f(rb, s0[r + 2], s0[r + 3]); ra = max3f(ra, s1[r], s1[r + 1]); rb = max3f(rb, s1[r + 2], s1[r + 3]); }
        float rm = fmaxf(ra, rb); rm = fmaxf(rm, swap32(rm));
        if (FIRST || __any(rm > RESC_THR)) {
            const float dl = FIRST ? rm : fmaxf(rm, 0.f);
            mref += dl;
            const float f = ex2(-dl);
            lsum *= f;
#pragma unroll
            for (int d = 0; d < NDB; ++d)
#pragma unroll
                for (int r = 0; r < 16; ++r) o[d][r] *= f;
#pragma unroll
            for (int r = 0; r < 16; ++r) { s0[r] -= dl; s1[r] -= dl; }
        }
        f32x16 n0, n1;
        qk(slot1, -mref, n0, n1);
        float ls = 0.f;
#pragma unroll
        for (int r = 0; r < 16; ++r) { s0[r] = ex2(s0[r]); s1[r] = ex2(s1[r]); ls += s0[r] + s1[r]; }
        lsum += ls;
        bf16x8 pw[4];
        { u32x4 w;
          w.x = cvtpk(s0[0], s0[1]); w.y = cvtpk(s0[2], s0[3]); w.z = cvtpk(s0[4], s0[5]); w.w = cvtpk(s0[6], s0[7]); pw[0] = __builtin_bit_cast(bf16x8, w);
          w.x = cvtpk(s0[8], s0[9]); w.y = cvtpk(s0[10], s0[11]); w.z = cvtpk(s0[12], s0[13]); w.w = cvtpk(s0[14], s0[15]); pw[1] = __builtin_bit_cast(bf16x8, w);
          w.x = cvtpk(s1[0], s1[1]); w.y = cvtpk(s1[2], s1[3]); w.z = cvtpk(s1[4], s1[5]); w.w = cvtpk(s1[6], s1[7]); pw[2] = __builtin_bit_cast(bf16x8, w);
          w.x = cvtpk(s1[8], s1[9]); w.y = cvtpk(s1[10], s1[11]); w.z = cvtpk(s1[12], s1[13]); w.w = cvtpk(s1[14], s1[15]); pw[3] = __builtin_bit_cast(bf16x8, w); }
        const LAS unsigned char* vb = lds + VOFF + slot * VBY + vlane;
#pragma unroll
        for (int d = 0; d < NDB; ++d)
#pragma unroll
            for (int ks = 0; ks < 4; ++ks) o[d] = mfma32(vfrag(vb + d * 4096 + ks * 1024), pw[ks], o[d]);
        s0 = n0; s1 = n1;
        slot = slot1;
    };
    typedef std::integral_constant<bool, true> T_; typedef std::integral_constant<bool, false> F_;
    int t = 1;
    if (CAUSAL) {
        if (NT == 2) step(0, T_(), T_()); else step(0, F_(), T_());
#pragma unroll 1
        for (; t < NT - 2; ++t) step(t, F_(), F_());
#pragma unroll 1
        for (; t < NT; ++t) step(t, T_(), F_());
    } else {
        step(0, F_(), T_());
#pragma unroll 1
        for (; t < NT; ++t) step(t, F_(), F_());
    }
    lsum += swap32(lsum);
    VM_WAIT(); LDS_WAIT(); __builtin_amdgcn_s_barrier();
}

__device__ __forceinline__ void diff_unit(LAS unsigned char* lds, const bf16_t* P, bf16_t* MIX, int b, int h, int qb, float lam, float oscale, const float* subln) {
    int tid = threadIdx.x; asm volatile("" : "+v"(tid));
    const int lane = tid & 63, r32 = lane & 31, hi = lane >> 5, wid = __builtin_amdgcn_readfirstlane(tid >> 6);
    const int map = wid >> 2, qs = wid & 3, q0w = qb * 128 + qs * 32;
    const size_t rowb = (size_t)b * SEQ;
    f32x16 o[4]; float lsum;
    flash_sweep<2, 128, true>(lds, P + (rowb + q0w + r32) * DIN + h * 128 + map * 64, P + rowb * DIN + 512 + h * 128, DIN, P + rowb * DIN + 1024 + h * 128, DIN,
                              2 * (qb + 1), q0w, o, lsum);
    const float inv = 1.f / lsum;
    LAS float* xch = (LAS float*)lds + qs * 4096;
    if (map == 1) {
#pragma unroll
        for (int d = 0; d < 4; ++d)
#pragma unroll
            for (int r = 0; r < 16; ++r) xch[(d * 16 + r) * 64 + lane] = o[d][r] * inv;
    }
    __syncthreads();
    if (map == 0) {
        float sq = 0.f;
#pragma unroll
        for (int d = 0; d < 4; ++d)
#pragma unroll
            for (int r = 0; r < 16; ++r) { const float v = o[d][r] * inv - lam * xch[(d * 16 + r) * 64 + lane]; o[d][r] = v; sq += v * v; }
        sq += swap32(sq);
        const float rs = __builtin_amdgcn_rsqf(sq * (1.f / 128.f) + EPS) * oscale;
        bf16_t* orow = MIX + (rowb + q0w + r32) * DM + h * 128;
#pragma unroll
        for (int d = 0; d < 4; ++d)
#pragma unroll
            for (int g4 = 0; g4 < 4; ++g4) {
                const int dd = 32 * d + 8 * g4 + 4 * hi;
                const f32x4 gn = *(const f32x4*)(subln + dd);
                u32x2 w; w.x = cvtpk(o[d][4 * g4] * rs * gn[0], o[d][4 * g4 + 1] * rs * gn[1]); w.y = cvtpk(o[d][4 * g4 + 2] * rs * gn[2], o[d][4 * g4 + 3] * rs * gn[3]);
                *(u32x2*)(orow + dd) = w;
            }
    }
    __syncthreads();
}

__device__ __forceinline__ void cross_unit(LAS unsigned char* lds, const bf16_t* QC, const bf16_t* KVC, bf16_t* OC, int b, int h, int qb, int layer) {
    int tid = threadIdx.x; asm volatile("" : "+v"(tid));
    const int lane = tid & 63, r32 = lane & 31, hi = lane >> 5, wid = __builtin_amdgcn_readfirstlane(tid >> 6);
    const size_t row = (size_t)b * SEQ + qb * 256 + wid * 32 + r32;
    const bf16_t* kbase = KVC + (size_t)b * MEML * 2048 + layer * 512 + h * 64;
    f32x16 o[2]; float lsum;
    flash_sweep<1, 64, false>(lds, QC + row * 256 + h * 64, kbase, 2048, kbase + 256, 2048, 4, 0, o, lsum);
    const float inv = 1.f / lsum;
    bf16_t* orow = OC + row * 256 + h * 64;
#pragma unroll
    for (int d = 0; d < 2; ++d)
#pragma unroll
        for (int g4 = 0; g4 < 4; ++g4) {
            u32x2 w; w.x = cvtpk(o[d][4 * g4] * inv, o[d][4 * g4 + 1] * inv); w.y = cvtpk(o[d][4 * g4 + 2] * inv, o[d][4 * g4 + 3] * inv);
            *(u32x2*)(orow + 32 * d + 8 * g4 + 4 * hi) = w;
        }
}

__device__ __forceinline__ void sb_wave_unit(LAS unsigned char* wl, const bf16_t* P, bf16_t* MIX, int b, int h, int blk, const float* gn_b) {
    int tid = threadIdx.x; asm volatile("" : "+v"(tid));
    const int lane = tid & 63, r32 = lane & 31, hi = lane >> 5;
    const size_t rowb = (size_t)b * SEQ;
    const bf16_t* Qrow = P + (rowb + 32 * blk + r32) * DIN + 1536 + h * 64;
    const bf16_t* Kb = P + rowb * DIN + 1792 + h * 64;
    const bf16_t* Vb = P + rowb * DIN + 2048 + h * 64;
    bf16x8 qf[4];
#pragma unroll
    for (int ks = 0; ks < 4; ++ks) qf[ks] = *(const bf16x8*)(Qrow + ks * 16 + hi * 8);
    f32x16 o[2];
    o[0] = (f32x16){0.f, 0.f, 0.f, 0.f, 0.f, 0.f, 0.f, 0.f, 0.f, 0.f, 0.f, 0.f, 0.f, 0.f, 0.f, 0.f}; o[1] = o[0];
    float C = 0.f;
    const int vlane = ((lane >> 4) & 1) * 32 + (lane & 3) * 8 + (4 * hi + ((lane & 15) >> 2)) * 64;
    for (int j = blk; j >= 0; --j) {
        const int key0 = 32 * j;
        bf16x8 kf[4]; u32x4 vv[4];
#pragma unroll
        for (int ks = 0; ks < 4; ++ks) kf[ks] = *(const bf16x8*)(Kb + (size_t)(key0 + r32) * DIN + ks * 16 + hi * 8);
#pragma unroll
        for (int p = 0; p < 4; ++p) vv[p] = *(const u32x4*)(Vb + (size_t)(key0 + 16 * (p & 1) + (lane >> 2)) * DIN + (p >> 1) * 32 + (lane & 3) * 8);
        f32x16 z = (f32x16){0.f, 0.f, 0.f, 0.f, 0.f, 0.f, 0.f, 0.f, 0.f, 0.f, 0.f, 0.f, 0.f, 0.f, 0.f, 0.f};
#pragma unroll
        for (int ks = 0; ks < 4; ++ks) z = mfma32(kf[ks], qf[ks], z);
#pragma unroll
        for (int p = 0; p < 4; ++p) *(LAS u32x4*)(wl + p * 1024 + lane * 16) = vv[p];
        const bool diag = (j == blk);
        float lk[16], lsg[16], gs[4], pg[4];
#pragma unroll
        for (int r = 0; r < 16; ++r) {
            const bool strict = !diag || (crow(r, hi) < r32);
            const float z2 = z[r];
            const float sp = fmaxf(z2, 0.f) + lg2(1.f + ex2(-fabsf(z2)));
            lk[r] = strict ? -sp : 0.f;
            lsg[r] = strict ? (z2 - sp) : -INFINITY;
        }
#pragma unroll
        for (int g = 0; g < 4; ++g) { gs[g] = (lk[4 * g] + lk[4 * g + 1]) + (lk[4 * g + 2] + lk[4 * g + 3]); pg[g] = swap32(gs[g]); }
        float sfx[4];
        { float own = 0.f, par = 0.f;
#pragma unroll
          for (int g = 3; g >= 0; --g) { sfx[g] = C + own + par + ((hi == 0) ? pg[g] : 0.f); own += gs[g]; par += pg[g]; }
          C += own + par; }
        float w[16];
#pragma unroll
        for (int g = 0; g < 4; ++g) {
            float run = sfx[g];
#pragma unroll
            for (int e = 3; e >= 0; --e) { w[4 * g + e] = ex2(lsg[4 * g + e] + run); run += lk[4 * g + e]; }
        }
        bf16x8 pw[2];
        { u32x4 t;
          t.x = cvtpk(w[0], w[1]); t.y = cvtpk(w[2], w[3]); t.z = cvtpk(w[4], w[5]); t.w = cvtpk(w[6], w[7]); pw[0] = __builtin_bit_cast(bf16x8, t);
          t.x = cvtpk(w[8], w[9]); t.y = cvtpk(w[10], w[11]); t.z = cvtpk(w[12], w[13]); t.w = cvtpk(w[14], w[15]); pw[1] = __builtin_bit_cast(bf16x8, t); }
#pragma unroll
        for (int d = 0; d < 2; ++d)
#pragma unroll
            for (int ks = 0; ks < 2; ++ks) o[d] = mfma32(vfrag(wl + vlane + d * 2048 + ks * 1024), pw[ks], o[d]);
        if (__all(C < -160.f)) break;
    }
    float sq = 0.f;
#pragma unroll
    for (int d = 0; d < 2; ++d)
#pragma unroll
        for (int r = 0; r < 16; ++r) sq += o[d][r] * o[d][r];
    sq += swap32(sq);
    const float rs = __builtin_amdgcn_rsqf(sq * (1.f / 64.f) + EPS);
    bf16_t* orow = MIX + (rowb + 32 * blk + r32) * DM + 512 + h * 64;
#pragma unroll
    for (int d = 0; d < 2; ++d)
#pragma unroll
        for (int g4 = 0; g4 < 4; ++g4) {
            const int dd = 32 * d + 8 * g4 + 4 * hi;
            const f32x4 gn = *(const f32x4*)(gn_b + h * 64 + dd);
            u32x2 t; t.x = cvtpk(o[d][4 * g4] * rs * gn[0], o[d][4 * g4 + 1] * rs * gn[1]); t.y = cvtpk(o[d][4 * g4 + 2] * rs * gn[2], o[d][4 * g4 + 3] * rs * gn[3]);
            *(u32x2*)(orow + dd) = t;
        }
}

__device__ __forceinline__ void sgu_pair(LAS unsigned char* lds, const bf16_t* P, bf16_t* MIX, int p, const float* sgn, const float* wsp, const float* bsp, const float* gno) {
    int tid = threadIdx.x; asm volatile("" : "+v"(tid));
    const int lane = tid & 63, r32 = lane & 31, hi = lane >> 5, wid = __builtin_amdgcn_readfirstlane(tid >> 6), half = wid >> 2, tb = wid & 3, tl = tid & 255;
    const int u = 2 * p + half, b = u >> 7, ch = (u >> 2) & 31, g = u & 3;
    const size_t row0 = (size_t)b * SEQ + ch * 128;
    LAS unsigned char* img = lds + half * 16384;
    {
        const int row = tl >> 1, hf = tl & 1;
        const bf16_t* vp = P + (row0 + row) * DIN + 2560 + g * 64 + hf * 32;
        u32x4 raw[4]; float v[32];
#pragma unroll
        for (int j = 0; j < 4; ++j) raw[j] = *(const u32x4*)(vp + 8 * j);
        float sq = 0.f;
#pragma unroll
        for (int j = 0; j < 4; ++j)
#pragma unroll
            for (int e = 0; e < 4; ++e) { v[8 * j + 2 * e] = bflo(raw[j][e]); v[8 * j + 2 * e + 1] = bfhi(raw[j][e]); sq += v[8 * j + 2 * e] * v[8 * j + 2 * e] + v[8 * j + 2 * e + 1] * v[8 * j + 2 * e + 1]; }
        sq += __shfl_xor(sq, 1);
        const float rs = __builtin_amdgcn_rsqf(sq * (1.f / 64.f) + EPS);
        const float* gp = sgn + g * 64 + hf * 32;
#pragma unroll
        for (int j = 0; j < 4; ++j) {
            const f32x4 g0 = *(const f32x4*)(gp + 8 * j), g1 = *(const f32x4*)(gp + 8 * j + 4);
            u32x4 w; w.x = cvtpk(v[8 * j] * rs * g0[0], v[8 * j + 1] * rs * g0[1]); w.y = cvtpk(v[8 * j + 2] * rs * g0[2], v[8 * j + 3] * rs * g0[3]);
            w.z = cvtpk(v[8 * j + 4] * rs * g1[0], v[8 * j + 5] * rs * g1[1]); w.w = cvtpk(v[8 * j + 6] * rs * g1[2], v[8 * j + 7] * rs * g1[3]);
            *(LAS u32x4*)(img + (hf * 8 + (row >> 4)) * 1024 + (row & 15) * 64 + j * 16) = w;
        }
    }
    __syncthreads();
    const int t = 32 * tb + r32;
    const int vlane = ((lane >> 4) & 1) * 32 + (lane & 3) * 8 + (4 * hi + ((lane & 15) >> 2)) * 64;
    f32x16 acc[2];
    acc[0] = (f32x16){0.f, 0.f, 0.f, 0.f, 0.f, 0.f, 0.f, 0.f, 0.f, 0.f, 0.f, 0.f, 0.f, 0.f, 0.f, 0.f}; acc[1] = acc[0];
    const float* wrow = wsp + (size_t)g * 16384 + (size_t)t * 128 + 4 * hi;
#pragma unroll 1
    for (int ks = 0; ks < 2 * tb + 2; ++ks) {
        const f32x4 w0 = *(const f32x4*)(wrow + 16 * ks), w1 = *(const f32x4*)(wrow + 16 * ks + 8);
        const int s0 = 16 * ks + 4 * hi;
        float wv[8];
#pragma unroll
        for (int e = 0; e < 4; ++e) { wv[e] = (s0 + e <= t) ? w0[e] : 0.f; wv[4 + e] = (s0 + 8 + e <= t) ? w1[e] : 0.f; }
        u32x4 wb; wb.x = cvtpk(wv[0], wv[1]); wb.y = cvtpk(wv[2], wv[3]); wb.z = cvtpk(wv[4], wv[5]); wb.w = cvtpk(wv[6], wv[7]);
        const bf16x8 bfrag = __builtin_bit_cast(bf16x8, wb);
        acc[0] = mfma32(vfrag(img + vlane + ks * 1024), bfrag, acc[0]);
        acc[1] = mfma32(vfrag(img + vlane + 8192 + ks * 1024), bfrag, acc[1]);
    }
    const float bias = bsp[g * 128 + t];
    const bf16_t* up = P + (row0 + t) * DIN + 2304 + g * 64;
    float sq = 0.f;
#pragma unroll
    for (int cb = 0; cb < 2; ++cb)
#pragma unroll
        for (int g4 = 0; g4 < 4; ++g4) {
            const u32x2 uu = *(const u32x2*)(up + 32 * cb + 8 * g4 + 4 * hi);
            const float o0 = bflo(uu.x) * (acc[cb][4 * g4] + bias), o1 = bfhi(uu.x) * (acc[cb][4 * g4 + 1] + bias), o2 = bflo(uu.y) * (acc[cb][4 * g4 + 2] + bias), o3 = bfhi(uu.y) * (acc[cb][4 * g4 + 3] + bias);
            acc[cb][4 * g4] = o0; acc[cb][4 * g4 + 1] = o1; acc[cb][4 * g4 + 2] = o2; acc[cb][4 * g4 + 3] = o3;
            sq += o0 * o0 + o1 * o1 + o2 * o2 + o3 * o3;
        }
    sq += swap32(sq);
    const float rs = __builtin_amdgcn_rsqf(sq * (1.f / 64.f) + EPS);
    bf16_t* orow = MIX + (row0 + t) * DM + 768 + g * 64;
#pragma unroll
    for (int cb = 0; cb < 2; ++cb)
#pragma unroll
        for (int g4 = 0; g4 < 4; ++g4) {
            const int c0 = 32 * cb + 8 * g4 + 4 * hi;
            const f32x4 gn = *(const f32x4*)(gno + g * 64 + c0);
            u32x2 w; w.x = cvtpk(acc[cb][4 * g4] * rs * gn[0], acc[cb][4 * g4 + 1] * rs * gn[1]); w.y = cvtpk(acc[cb][4 * g4 + 2] * rs * gn[2], acc[cb][4 * g4 + 3] * rs * gn[3]);
            *(u32x2*)(orow + c0) = w;
        }
    __syncthreads();
}

__device__ __forceinline__ void transpose_item(const float* W, int N, const float* gain, bf16_t* WT, int ldt, int k0, int n0, LAS float* scr, int lane) {
    f32x4 v[16];
#pragma unroll
    for (int i = 0; i < 16; ++i) v[i] = *(const f32x4*)(W + (size_t)(k0 + 4 * i + (lane >> 4)) * N + n0 + (lane & 15) * 4);
#pragma unroll
    for (int i = 0; i < 16; ++i) {
        const int k = 4 * i + (lane >> 4);
        const float gk = gain ? gain[k0 + k] : 1.f;
#pragma unroll
        for (int e = 0; e < 4; ++e) scr[k * 65 + (lane & 15) * 4 + e] = v[i][e] * gk;
    }
    LDS_WAIT();
    const int kc = lane >> 3;
#pragma unroll
    for (int j = 0; j < 8; ++j) {
        const int n = 8 * j + (lane & 7);
        const LAS float* s = scr + (8 * kc) * 65 + n;
        u32x4 o; o.x = cvtpk(s[0], s[65]); o.y = cvtpk(s[2 * 65], s[3 * 65]); o.z = cvtpk(s[4 * 65], s[5 * 65]); o.w = cvtpk(s[6 * 65], s[7 * 65]);
        *(u32x4*)(WT + (size_t)(n0 + n) * ldt + k0 + 8 * kc) = o;
    }
    LDS_WAIT();
}

struct Args {
    const float* x; const float* mem; const int* pos; const float* norm_mix; const float* w_in; const float* lam_q1; const float* lam_k1; const float* lam_q2; const float* lam_k2;
    const float* subln_a; const float* norm_b_out; const float* sgu_norm; const float* w_spatial; const float* b_spatial; const float* norm_c_out; const float* w_out;
    const float* norm_cross; const float* norm_mem; const float* w_cq; const float* w_ck; const float* w_cv; const float* w_co; const float* norm_ffn;
    const float* w_group; const float* b_group; const float* w_router; const float* b_router; const float* w_gate; const float* w_up; const float* w_down; const float* norm_final;
    float* out; unsigned char* ws; int ph_lo, ph_hi;
};
constexpr int PH_PER_LAYER = 10, PH_LAYER0 = 2, PH_FINAL = PH_LAYER0 + DEPTH * PH_PER_LAYER, N_PHASES = PH_FINAL + 1;

typedef __attribute__((address_space(4))) const Args* KArgP;
__device__ __forceinline__ KArgP kargs() { KArgP p = (KArgP)__builtin_amdgcn_kernarg_segment_ptr(); asm volatile("" : "+s"(p)); return p; }
#define KA (kargs())
template <class T> __device__ __forceinline__ T* asg(T* p) { GAS T* q = (GAS T*)p; asm volatile("" : "+s"(q)); return (T*)q; }
__device__ __forceinline__ unsigned char* opq(unsigned char* p) { return asg(p); }
#define X ((float*)(opq(ws) + WS_X))
#define XB ((bf16_t*)(opq(ws) + WS_XB))
#define PROJ ((bf16_t*)(opq(ws) + WS_PROJ))
#define MIX ((bf16_t*)(opq(ws) + WS_MIX))
#define QC ((bf16_t*)(opq(ws) + WS_QC))
#define OC ((bf16_t*)(opq(ws) + WS_OC))
#define HS ((bf16_t*)(opq(ws) + WS_HS))
#define ACT ((bf16_t*)(opq(ws) + WS_ACT))
#define MEMBF ((bf16_t*)(opq(ws) + WS_MEMBF))
#define KVC ((bf16_t*)(opq(ws) + WS_KVC))
#define WIN ((bf16_t*)(opq(ws) + WS_WIN))
#define WOUT ((bf16_t*)(opq(ws) + WS_WOUT))
#define WCKV ((bf16_t*)(opq(ws) + WS_WCKV))
#define WCQ ((bf16_t*)(opq(ws) + WS_WCQ))
#define WCO ((bf16_t*)(opq(ws) + WS_WCO))
#define WGU ((bf16_t*)(opq(ws) + WS_WGU))
#define WD ((bf16_t*)(opq(ws) + WS_WD))
#define SS0 ((float*)(opq(ws) + WS_SS0))
#define SS1 ((float*)(opq(ws) + WS_SS1))
#define SSMEM ((float*)(opq(ws) + WS_SSMEM))
#define LAMV ((float*)(opq(ws) + WS_LAMV))
#define GWT ((float*)(opq(ws) + WS_GWT))
#define RSTD2 ((float*)(opq(ws) + WS_RSTD2))
#define CTOK ((int*)(opq(ws) + WS_CTOK))
#define CRS ((float*)(opq(ws) + WS_CRS))
#define CWT ((float*)(opq(ws) + WS_CWT))
#define ROT ((float*)(opq(ws) + WS_ROT))
#define SLOTTOK ((int*)(opq(ws) + WS_SLOTTOK))
#define SLOTW ((float*)(opq(ws) + WS_SLOTW))
__global__ void __launch_bounds__(NTHR, 2) fwd_kernel(Args a) {
    extern __shared__ __attribute__((aligned(16))) unsigned char lds_raw[];
    LAS unsigned char* lds = (LAS unsigned char*)lds_raw;
    volatile LAS unsigned* MISC = (volatile LAS unsigned*)(lds + MISC_OFF);
    const int tid = threadIdx.x, lane = tid & 63, wave = __builtin_amdgcn_readfirstlane(tid >> 6);
    const int G = gridDim.x, bx = blockIdx.x, vcu = (G % 8 == 0) ? (bx % 8) * (G / 8) + bx / 8 : bx;
    unsigned char* ws = a.ws;
    gu32* ctl = (gu32*)(ws + WS_CTL);
    for (int u = tid; u < (LDS_BYTES - MISC_OFF) / 4; u += NTHR) MISC[u] = 0u;
    __syncthreads();
    XcdBarrier bar; bar.bar = (unsigned*)ctl + CW_BAR; bar.x = 0; bar.st = nullptr;
    if (!MK_MULTI) bar = xcd_barrier_post((unsigned*)ctl + CW_BAR, MISC);
    const int lo = a.ph_lo, hi_ph = a.ph_hi;
#ifndef PHEN
#define PHEN 0xffff
#endif
#define EN(b) ((PHEN >> (b)) & 1)
#ifndef REPM
#define REPM 0
#endif
#define REPN(b) (((REPM >> (b)) & 1) ? 2 : 1)
#define IN(k) (lo <= (k) && (k) < hi_ph)
#define SEAM(k) do { if (!MK_MULTI && IN(k) && IN((k) + 1)) { xcd_barrier(bar); if (REPN(15) == 2) xcd_barrier(bar); } } while (0)

    const int gw_ = vcu * NWAVES + wave, NGW = G * NWAVES;

    if (EN(0) && IN(0)) for (int rep_ = 0; rep_ < REPN(0); ++rep_) {
        int tid = threadIdx.x; asm volatile("" : "+v"(tid)); const int lane = tid & 63; int gw = gw_; asm volatile("" : "+s"(gw));
        LAS float* scr = (LAS float*)(lds + wave * 16640);
        constexpr int I_GU = 128 * 128, I_D = 64 * 128, I_IN = 4 * 16 * 44, I_OUT = 4 * 256, I_C3 = 12 * 64, I_CO = 4 * 64;
        constexpr int NITEMS = I_GU + I_D + I_IN + I_OUT + I_C3 + I_CO;
        for (int it = gw; it < NITEMS; it += NGW) {
            int r = it;
            if (r < I_GU) { const int mtx = r >> 7, t = r & 127, le = mtx >> 1, up = mtx & 1, kb = t >> 3, nb = t & 7;
                transpose_item((up ? asg(KA->w_up) : asg(KA->w_gate)) + (size_t)le * 1024 * 512, 512, asg(KA->norm_ffn) + (le >> 4) * 1024, WGU + ((size_t)le * 1024 + up * 512) * 1024, 1024, kb * 64, nb * 64, scr, lane); continue; }
            r -= I_GU;
            if (r < I_D) { const int le = r >> 7, t = r & 127, kb = t >> 4, nb = t & 15;
                transpose_item(asg(KA->w_down) + (size_t)le * 512 * 1024, 1024, nullptr, WD + (size_t)le * 1024 * 512, 512, kb * 64, nb * 64, scr, lane); continue; }
            r -= I_D;
            if (r < I_IN) { const int l = r / 704, t = r % 704, kb = t / 44, nb = t % 44;
                transpose_item(asg(KA->w_in) + (size_t)l * 1024 * DIN, DIN, asg(KA->norm_mix) + l * 1024, WIN + (size_t)l * DIN * 1024, 1024, kb * 64, nb * 64, scr, lane); continue; }
            r -= I_IN;
            if (r < I_OUT) { const int l = r >> 8, t = r & 255, kb = t >> 4, nb = t & 15;
                transpose_item(asg(KA->w_out) + (size_t)l * 1024 * 1024, 1024, nullptr, WOUT + (size_t)l * 1024 * 1024, 1024, kb * 64, nb * 64, scr, lane); continue; }
            r -= I_OUT;
            if (r < I_C3) { const int mtx = r >> 6, t = r & 63, l = mtx / 3, which = mtx % 3, kb = t >> 2, nb = t & 3;
                const float* src = (which == 0 ? asg(KA->w_ck) : which == 1 ? asg(KA->w_cv) : asg(KA->w_cq)) + (size_t)l * 1024 * 256;
                bf16_t* dst = (which == 2) ? WCQ + (size_t)l * 256 * 1024 : WCKV + ((size_t)l * 512 + which * 256) * 1024;
                transpose_item(src, 256, (which == 2 ? asg(KA->norm_cross) : asg(KA->norm_mem)) + l * 1024, dst, 1024, kb * 64, nb * 64, scr, lane); continue; }
            r -= I_C3;
            { const int l = r >> 6, t = r & 63, kb = t >> 4, nb = t & 15;
              transpose_item(asg(KA->w_co) + (size_t)l * 256 * 1024, 1024, nullptr, WCO + (size_t)l * 1024 * 256, 256, kb * 64, nb * 64, scr, lane); }
        }
        for (int m = gw; m < MTOK + MROWS; m += NGW) {
            const bool ismem = (m >= MTOK);
            const float* src = ismem ? asg(KA->mem) + (size_t)(m - MTOK) * DM : asg(KA->x) + (size_t)m * DM;
            bf16_t* dst = ismem ? MEMBF + (size_t)(m - MTOK) * DM : XB + (size_t)m * DM;
            float s = 0.f;
#pragma unroll
            for (int j = 0; j < 4; ++j) { const f32x4 v = *(const f32x4*)(src + j * 256 + lane * 4); s += v[0] * v[0] + v[1] * v[1] + v[2] * v[2] + v[3] * v[3];
                u32x2 w; w.x = cvtpk(v[0], v[1]); w.y = cvtpk(v[2], v[3]); *(u32x2*)(dst + j * 256 + lane * 4) = w; }
            s = wave_sum(s);
            if (ismem) { if (lane == 0) SSMEM[m - MTOK] = s; } else if (lane < 16) SS0[(size_t)m * 16 + lane] = (lane == 0) ? s : 0.f;
        }
        for (int i = bx * NTHR + tid; i < MTOK * 8; i += G * NTHR) {
            const int row = i >> 3, k = i & 7;
            const float invf = (float)exp2(-(double)k * (18.931568569324174 / 8.0));
            const float ang = (float)asg(KA->pos)[row] * invf;
            const double rev = (double)ang * 0.15915494309189535;
            const float fr = (float)(rev - floor(rev));
            ROT[(size_t)row * 16 + k] = __builtin_amdgcn_cosf(fr); ROT[(size_t)row * 16 + 8 + k] = __builtin_amdgcn_sinf(fr);
        }
        for (int i = bx * NTHR + tid; i < DEPTH * 20 * 1024; i += G * NTHR) {
            const int l = i / 20480, j = (i >> 10) % 20, k = i & 1023;
            const float w = (j < 4) ? asg(KA->w_group)[(size_t)l * 4096 + k * 4 + j] : asg(KA->w_router)[(size_t)l * 16384 + k * 16 + (j - 4)];
            GWT[i] = w * asg(KA->norm_ffn)[l * 1024 + k];
        }
        if (bx == 0 && wave == 0) {
            for (int l = 0; l < DEPTH; ++l) {
                const float s1 = wave_sum(asg(KA->lam_q1)[l * 64 + lane] * asg(KA->lam_k1)[l * 64 + lane]), s2 = wave_sum(asg(KA->lam_q2)[l * 64 + lane] * asg(KA->lam_k2)[l * 64 + lane]);
                const float lam_init = 0.8f - 0.6f * expf(-0.3f * (float)l);
                if (lane == 0) LAMV[l] = expf(s1) - expf(s2) + lam_init;
            }
        }
    }
    SEAM(0);
    if (EN(1) && IN(1)) {
        pg8::DenseOrder S; S.init(MEMBF, WCKV, DM, DM, MROWS, 2048, G, bx);
        pg8::GemmP g{DM, DM, DM, (size_t)128 * DM * 2, 1 << 20};
        EpiScale E{KVC, 2048, SSMEM, 1, 1.f};
        pg8::gemm_phase(lds, g, S, E);
    }
    SEAM(1);

#pragma unroll 1
    for (int l = 0; l < DEPTH; ++l) {
        const int p0 = PH_LAYER0 + l * PH_PER_LAYER;
        const float lam_init = 0.8f - 0.6f * expf(-0.3f * (float)l);
        if (EN(2) && IN(p0 + 0)) for (int rep_ = 0; rep_ < REPN(2); ++rep_) {
            pg8::DenseOrder S; S.init(XB, WIN + (size_t)l * DIN * DM, DM, DM, MTOK, DIN, G, bx);
            pg8::GemmP g{DM, DM, DM, (size_t)128 * DM * 2, 1 << 20};
            EpiInProj E{PROJ, SS0, ROT};
            pg8::gemm_phase(lds, g, S, E);
        }
        SEAM(p0 + 0);
        if (IN(p0 + 1)) for (int rep_ = 0; rep_ < REPN(1); ++rep_) {
            int gw = gw_; asm volatile("" : "+s"(gw));
            const float lam = LAMV[l];
            if (EN(12)) for (int r2_ = 0; r2_ < REPN(12); ++r2_) {
                const int j = vcu & 31, bhp = 2 * (vcu >> 5) + (j >> 4), sq = j & 15;
                const int nun = (G == 256) ? 2 : (512 - bx + G - 1) / G;
#pragma unroll 1
                for (int i = 0; i < nun; ++i) {
                    int bh, qb;
                    if (G == 256) { bh = bhp; qb = (i == 0) ? 31 - sq : sq; } else { const int u = bx + i * G; bh = u >> 5; qb = u & 31; }
                    diff_unit(lds, PROJ, MIX, bh >> 2, bh & 3, qb, lam, 1.f - lam_init, asg(KA->subln_a) + l * 128);
                }
            }
            if (EN(13)) for (int r2_ = 0; r2_ < REPN(13); ++r2_) for (int u = gw; u < 2048; u += NGW) { const int bh = u >> 7; sb_wave_unit(lds + wave * 4096, PROJ, MIX, bh >> 2, bh & 3, u & 127, asg(KA->norm_b_out) + l * 256); }
            __syncthreads();
            if (EN(14)) for (int r2_ = 0; r2_ < REPN(14); ++r2_) for (int p = bx; p < 256; p += G)
                sgu_pair(lds, PROJ, MIX, p, asg(KA->sgu_norm) + l * 256, asg(KA->w_spatial) + (size_t)l * 4 * 16384, asg(KA->b_spatial) + l * 512, asg(KA->norm_c_out) + l * 256);
        }
        SEAM(p0 + 1);
        if (EN(3) && IN(p0 + 2)) {
            pg8::DenseOrder S; S.init(MIX, WOUT + (size_t)l * DM * DM, DM, DM, MTOK, DM, G, bx);
            pg8::GemmP g{DM, DM, DM, (size_t)128 * DM * 2, 1 << 20};
            EpiResid E{l == 0 ? asg(KA->x) : X, X, XB, SS1, nullptr, 0};
            if (REPN(3) == 2) { EpiResid E2{l == 0 ? asg(KA->x) : X, (float*)HS, HS + 16 * 1024 * 1024, nullptr, nullptr, 1}; pg8::gemm_phase(lds, g, S, E2); }
            pg8::gemm_phase(lds, g, S, E);
        }
        SEAM(p0 + 2);
        if (EN(4) && IN(p0 + 3)) for (int rep_ = 0; rep_ < REPN(4); ++rep_) {
            pg8::DenseOrder S; S.init(XB, WCQ + (size_t)l * 256 * DM, DM, DM, MTOK, 256, G, bx);
            pg8::GemmP g{DM, DM, DM, (size_t)128 * DM * 2, 1 << 20};
            EpiScale E{QC, 256, SS1, 16, 0.125f * LOG2E};
            pg8::gemm_phase(lds, g, S, E);
        }
        SEAM(p0 + 3);
        if (EN(5) && IN(p0 + 4)) for (int rep_ = 0; rep_ < REPN(5); ++rep_) {
            for (int u = bx; u < 256; u += G) cross_unit(lds, QC, KVC, OC, u >> 6, (u >> 4) & 3, u & 15, l);
        }
        SEAM(p0 + 4);
        if (EN(6) && IN(p0 + 5)) {
            pg8::DenseOrder S; S.init(OC, WCO + (size_t)l * DM * 256, 256, 256, MTOK, DM, G, bx);
            pg8::GemmP g{256, 256, 256, (size_t)128 * 256 * 2, 1 << 20};
            EpiResid E{X, X, XB, nullptr, nullptr, 0};
            if (REPN(6) == 2) { EpiResid E2{X, (float*)HS, HS + 16 * 1024 * 1024, nullptr, nullptr, 1}; pg8::gemm_phase(lds, g, S, E2); }
            pg8::gemm_phase(lds, g, S, E);
        }
        SEAM(p0 + 5);
        if (EN(7) && IN(p0 + 6)) for (int rep_ = 0; rep_ < REPN(7); ++rep_) {
            int tid = threadIdx.x; asm volatile("" : "+v"(tid)); const int lane = tid & 63; int gw = gw_; asm volatile("" : "+s"(gw));
            LAS float* gW = (LAS float*)lds;
            { const float* gsrc = GWT + (size_t)l * 20480;
              for (int i = tid; i < 5120; i += NTHR) { const int j = i >> 8, m4 = i & 255; *(LAS f32x4*)(gW + j * 1028 + 4 * m4) = *(const f32x4*)(gsrc + j * 1024 + 4 * m4); } }
            __syncthreads();
#pragma unroll 1
            for (int tb = vcu; tb < MTOK / 64; tb += G) {
                const int m = tb * 64 + (tid >> 3), kp = tid & 7;
                const float* xrow = X + (size_t)m * DM + kp * 4;
                float s = 0.f, d[4] = {0.f, 0.f, 0.f, 0.f};
#pragma unroll 1
                for (int h = 0; h < 2; ++h) {
                    f32x4 xr[16];
#pragma unroll
                    for (int i = 0; i < 16; ++i) xr[i] = *(const f32x4*)(xrow + (h * 16 + i) * 32);
#pragma unroll
                    for (int i = 0; i < 16; ++i) {
                        s += xr[i][0] * xr[i][0] + xr[i][1] * xr[i][1] + xr[i][2] * xr[i][2] + xr[i][3] * xr[i][3];
#pragma unroll
                        for (int j = 0; j < 4; ++j) { const f32x4 w = *(const LAS f32x4*)(gW + j * 1028 + ((h * 16 + i) * 8 + kp) * 4); d[j] += xr[i][0] * w[0] + xr[i][1] * w[1] + xr[i][2] * w[2] + xr[i][3] * w[3]; }
                    }
                }
#pragma unroll
                for (int o = 1; o < 8; o <<= 1) { s += __shfl_xor(s, o);
#pragma unroll
                    for (int j = 0; j < 4; ++j) d[j] += __shfl_xor(d[j], o); }
                const float rstd = 1.f / sqrtf(s * (1.f / DM) + EPS);
                float gl[4]; int gi = 0;
#pragma unroll
                for (int j = 0; j < 4; ++j) gl[j] = d[j] * rstd + asg(KA->b_group)[l * 4 + j];
                float gmax = gl[0];
#pragma unroll
                for (int j = 1; j < 4; ++j) if (gl[j] > gmax) { gmax = gl[j]; gi = j; }
                float den = 0.f;
#pragma unroll
                for (int j = 0; j < 4; ++j) den += expf(gl[j] - gmax);
                const float pgrp = 1.f / den;
                float el[4] = {0.f, 0.f, 0.f, 0.f};
                { const LAS float* gr = gW + (4 + 4 * gi) * 1028;
#pragma unroll 1
                  for (int h = 0; h < 2; ++h) {
                      f32x4 xr[16];
#pragma unroll
                      for (int i = 0; i < 16; ++i) xr[i] = *(const f32x4*)(xrow + (h * 16 + i) * 32);
#pragma unroll
                      for (int i = 0; i < 16; ++i)
#pragma unroll
                          for (int j = 0; j < 4; ++j) { const f32x4 w = *(const LAS f32x4*)(gr + j * 1028 + ((h * 16 + i) * 8 + kp) * 4); el[j] += xr[i][0] * w[0] + xr[i][1] * w[1] + xr[i][2] * w[2] + xr[i][3] * w[3]; }
                  } }
#pragma unroll
                for (int o = 1; o < 8; o <<= 1)
#pragma unroll
                    for (int j = 0; j < 4; ++j) el[j] += __shfl_xor(el[j], o);
#pragma unroll
                for (int j = 0; j < 4; ++j) el[j] = el[j] * rstd + asg(KA->b_router)[l * 16 + 4 * gi + j];
                int i0 = 0, i1 = -1; float v0 = el[0], v1 = -INFINITY;
#pragma unroll
                for (int j = 1; j < 4; ++j) if (el[j] > v0) { v0 = el[j]; i0 = j; }
#pragma unroll
                for (int j = 0; j < 4; ++j) if (j != i0 && el[j] > v1) { v1 = el[j]; i1 = j; }
                const float e1 = expf(v1 - v0), w0 = pgrp / (1.f + e1), w1 = pgrp * e1 / (1.f + e1);
                const int elo = i0 < i1 ? i0 : i1, ehi = i0 < i1 ? i1 : i0;
                const float wlo = i0 < i1 ? w0 : w1, whi = i0 < i1 ? w1 : w0;
                const int pidx = (elo == 0) ? (ehi - 1) : (elo == 1 ? ehi + 1 : 5);
                const int bkt = gi * 6 + pidx;
                if (kp == 0 && rep_ == REPN(7) - 1) {
                    const unsigned pos = __hip_atomic_fetch_add((unsigned*)ctl + CW_CNT + 32 * l + bkt, 1u, __ATOMIC_RELAXED, __HIP_MEMORY_SCOPE_AGENT);
                    SLOTTOK[(size_t)bkt * SLOTCAP + pos] = m;
                    SLOTW[((size_t)bkt * SLOTCAP + pos) * 2] = wlo; SLOTW[((size_t)bkt * SLOTCAP + pos) * 2 + 1] = whi;
                    RSTD2[m] = rstd;
                }
            }
        }
        SEAM(p0 + 6);
        if (IN(p0 + 7) || IN(p0 + 8) || IN(p0 + 9)) {
            __syncthreads();
            if (tid == 0) { int acc = 0;
#pragma unroll 1
                for (int b = 0; b < NBUCKET; ++b) { MISC[16 + b] = (unsigned)acc;
                    const int nt_b = (int)((__hip_atomic_load((unsigned*)ctl + CW_CNT + 32 * l + b, __ATOMIC_RELAXED, __HIP_MEMORY_SCOPE_AGENT) + 255u) >> 8);
#pragma unroll 1
                    for (int q = 0; q < nt_b; ++q) MISC[48 + acc + q] = (unsigned)b;
                    acc += nt_b; }
                MISC[16 + NBUCKET] = (unsigned)acc; }
            __syncthreads();
        }
        const volatile LAS int* pre = (const volatile LAS int*)(MISC + 16);
        if (EN(8) && IN(p0 + 7)) for (int rep_ = 0; rep_ < REPN(8); ++rep_) {
            int tid = threadIdx.x; asm volatile("" : "+v"(tid)); const int lane = tid & 63; int gw = gw_; asm volatile("" : "+s"(gw));
            const int ncr = pre[NBUCKET] * 256;
            for (int cr = gw; cr < ncr; cr += NGW) {
                const int rt = cr >> 8;
                const int b = pre[32 + rt];
                const int idx = (rt - pre[b]) * 256 + (cr & 255);
                const int cnt = (int)__hip_atomic_load((unsigned*)ctl + CW_CNT + 32 * l + b, __ATOMIC_RELAXED, __HIP_MEMORY_SCOPE_AGENT);
                const bool valid = idx < cnt;
                const int tok = valid ? SLOTTOK[(size_t)b * SLOTCAP + idx] : -1;
                u32x4 v0 = (u32x4){0u, 0u, 0u, 0u}, v1 = v0;
                if (valid) { v0 = *(const u32x4*)(XB + (size_t)tok * DM + lane * 8); v1 = *(const u32x4*)(XB + (size_t)tok * DM + 512 + lane * 8); }
                *(u32x4*)(HS + (size_t)cr * DM + lane * 8) = v0; *(u32x4*)(HS + (size_t)cr * DM + 512 + lane * 8) = v1;
                if (lane == 0) { CTOK[cr] = tok; CRS[cr] = valid ? RSTD2[tok] : 0.f;
                    CWT[2 * cr] = valid ? SLOTW[((size_t)b * SLOTCAP + idx) * 2] : 0.f; CWT[2 * cr + 1] = valid ? SLOTW[((size_t)b * SLOTCAP + idx) * 2 + 1] : 0.f; }
            }
        }
        SEAM(p0 + 7);
        if (EN(9) && IN(p0 + 8)) for (int rep_ = 0; rep_ < REPN(9); ++rep_) {
            MoeOrder S{pre, (const char*)HS, (const char*)WGU, l, G, vcu, false};
            pg8::GemmP g{DM, DM, DM, (size_t)512 * DM * 2, 1 << 20};
            EpiG1 E{ACT, CRS, CWT};
            pg8::gemm_phase(lds, g, S, E);
        }
        SEAM(p0 + 8);
        if (EN(10) && IN(p0 + 9)) {
            MoeOrder S{pre, (const char*)ACT, (const char*)WD, l, G, vcu, true};
            pg8::GemmP g{DM, 512, DM, (size_t)128 * 512 * 2, 8};
            EpiResid E{X, X, XB, SS0, CTOK, 0};
            if (REPN(10) == 2) { EpiResid E2{X, (float*)HS, HS + 16 * 1024 * 1024, nullptr, CTOK, 1}; pg8::gemm_phase(lds, g, S, E2); }
            pg8::gemm_phase(lds, g, S, E);
        }
        SEAM(p0 + 9);
    }
    if (EN(11) && IN(PH_FINAL)) {
        int tid = threadIdx.x; asm volatile("" : "+v"(tid)); const int lane = tid & 63; int gw = gw_; asm volatile("" : "+s"(gw));
        for (int m = gw; m < MTOK; m += NGW) {
            f32x4 v[4]; float sq = 0.f;
#pragma unroll
            for (int j = 0; j < 4; ++j) { v[j] = *(const f32x4*)(X + (size_t)m * DM + j * 256 + lane * 4); sq += v[j][0] * v[j][0] + v[j][1] * v[j][1] + v[j][2] * v[j][2] + v[j][3] * v[j][3]; }
            const float rs = 1.f / sqrtf(wave_sum(sq) * (1.f / DM) + EPS);
#pragma unroll
            for (int j = 0; j < 4; ++j) { const f32x4 gn = *(const f32x4*)(asg(KA->norm_final) + j * 256 + lane * 4);
                *(f32x4*)(asg(KA->out) + (size_t)m * DM + j * 256 + lane * 4) = v[j] * rs * gn; }
        }
    }
#undef IN
#undef SEAM
}
#undef X
#undef XB
#undef PROJ
#undef MIX
#undef QC
#undef OC
#undef HS
#undef ACT
#undef MEMBF
#undef KVC
#undef WIN
#undef WOUT
#undef WCKV
#undef WCQ
#undef WCO
#undef WGU
#undef WD
#undef SS0
#undef SS1
#undef SSMEM
#undef LAMV
#undef GWT
#undef RSTD2
#undef CTOK
#undef CRS
#undef CWT
#undef ROT
#undef SLOTTOK
#undef SLOTW

extern "C" void kernel_launch(void* const* d_in, const int* in_sizes, int n_in, void* d_out, int out_size, void* d_ws, size_t ws_size, hipStream_t stream) {
    static int grid = 0;
    if (grid == 0) {
        if (n_in != 31 || in_sizes[0] != MTOK * DM || out_size != MTOK * DM || ws_size < WS_END) {
            fprintf(stderr, "kernel_launch: unexpected problem (n_in %d, in0 %d, out %d, ws %zu; need ws >= %zu); nothing launched\n", n_in, n_in > 0 ? in_sizes[0] : -1, out_size, ws_size, (size_t)WS_END); grid = -1; return; }
        int dev = 0, cus = 0, per_cu = 0;
        if (hipGetDevice(&dev) != hipSuccess || hipDeviceGetAttribute(&cus, hipDeviceAttributeMultiprocessorCount, dev) != hipSuccess) { grid = -1; return; }
        if (hipFuncSetAttribute((const void*)fwd_kernel, hipFuncAttributeMaxDynamicSharedMemorySize, LDS_BYTES) != hipSuccess) { fprintf(stderr, "kernel_launch: hipFuncSetAttribute failed\n"); grid = -1; return; }
        if (hipOccupancyMaxActiveBlocksPerMultiprocessor(&per_cu, (const void*)fwd_kernel, NTHR, LDS_BYTES) != hipSuccess || per_cu < 1) {
            fprintf(stderr, "kernel_launch: occupancy query reports %d workgroups per CU\n", per_cu); }
        (void)hipGetLastError();
        grid = cus;
    }
    if (grid < 0) return;
    if (hipMemsetAsync((char*)d_ws + WS_CTL, 0, CTL_ZERO_BYTES, stream) != hipSuccess) return;
    Args a{};
    const float** fp = (const float**)&a;
    for (int i = 0; i < 31; ++i) fp[i] = (const float*)d_in[i];
    a.out = (float*)d_out; a.ws = (unsigned char*)d_ws;
#if MK_MULTI
    for (int p = 0; p < N_PHASES; ++p) { a.ph_lo = p; a.ph_hi = p + 1; hipLaunchKernelGGL(fwd_kernel, dim3(grid), dim3(NTHR), LDS_BYTES, stream, a); }
#else
    a.ph_lo = 0; a.ph_hi = N_PHASES;
    hipLaunchKernelGGL(fwd_kernel, dim3(grid), dim3(NTHR), LDS_BYTES, stream, a);
#endif
}
```
